# Optimizing an MI355X kernel written in HIP

```python
import math
import jax, jax.numpy as jnp
from jax import lax
import numpy as np

D_MODEL = 1024
BATCH = 8
SEQ = 2048
DEPTH = 4

CHUNK = 64
Q_BLOCK = 128
N_EVEN = (DEPTH + 1) // 2
N_ODD = DEPTH // 2

POOL_WINDOWS = (2, 4, 8, 16)
POOL_GROUPS = len(POOL_WINDOWS)
POOL_GROUP_WIDTH = D_MODEL // 8
POOL_WIDTH = POOL_GROUPS * POOL_GROUP_WIDTH
LRU_WIDTH = D_MODEL
LRU_HEADS = 8
LRU_HEAD_DIM = LRU_WIDTH // LRU_HEADS
CONV_WIDTH = 4
LRU_C = 8.0
EVEN_IN_WIDTH = POOL_WIDTH + 2 * LRU_WIDTH
EVEN_MIX_WIDTH = POOL_WIDTH + LRU_WIDTH
MLA_HEADS = 8
QK_NOPE_DIM = 128
QK_ROPE_DIM = 64
V_HEAD_DIM = 128
Q_LORA_RANK = 384
KV_LORA_RANK = 256
ODD_IN_WIDTH = Q_LORA_RANK + KV_LORA_RANK + QK_ROPE_DIM
ROPE_THETA = 10000.0
D_FF = 4 * D_MODEL
DEEPNORM_ALPHA = (2 * DEPTH) ** 0.25
DEEPNORM_BETA = (8 * DEPTH) ** -0.25
LN_EPS = 1e-5
RMS_EPS = 1e-6

kernel_name = "pool_rglru_mla_deepnorm_hybrid"


def layer_norm(x, g, b):
    xf = x.astype(jnp.float32)
    mu = jnp.mean(xf, axis=-1, keepdims=True)
    var = jnp.mean(jnp.square(xf - mu), axis=-1, keepdims=True)
    y = (xf - mu) * lax.rsqrt(var + LN_EPS) * g.astype(jnp.float32) + b.astype(jnp.float32)
    return y.astype(x.dtype)


def rms_norm(x, g):
    xf = x.astype(jnp.float32)
    y = xf * lax.rsqrt(jnp.mean(jnp.square(xf), axis=-1, keepdims=True) + RMS_EPS) * g.astype(jnp.float32)
    return y.astype(x.dtype)


def rope_tables(positions):
    inv_freq = ROPE_THETA ** (-jnp.arange(0, QK_ROPE_DIM, 2, dtype=jnp.float32) / QK_ROPE_DIM)
    ang = positions.astype(jnp.float32)[..., None] * inv_freq
    return jnp.cos(ang), jnp.sin(ang)


def apply_rope(x, cos, sin):
    xf = x.astype(jnp.float32)
    x1, x2 = jnp.split(xf, 2, axis=-1)
    return jnp.concatenate([x1 * cos - x2 * sin, x1 * sin + x2 * cos], axis=-1).astype(x.dtype)


def multiscale_pool(u, w_pool, pool_scale):
    b, s, _ = u.shape
    ug = u.astype(jnp.float32).reshape(b, s, POOL_GROUPS, POOL_GROUP_WIDTH)
    csum = jnp.cumsum(ug, axis=1)
    t = jnp.arange(s)
    diffs = []
    for g, w in enumerate(POOL_WINDOWS):
        cg = csum[:, :, g]
        lagged = jnp.pad(cg, ((0, 0), (w, 0), (0, 0)))[:, :s]
        count = jnp.minimum(t + 1, w).astype(jnp.float32)[None, :, None]
        diffs.append((cg - lagged) / count - ug[:, :, g])
    d = jnp.stack(diffs, axis=2)
    y = jnp.einsum('bsgc,gcd->bsgd', d, w_pool.astype(jnp.float32))
    y = y.reshape(b, s, POOL_WIDTH) * pool_scale.astype(jnp.float32)
    return y.astype(u.dtype)


def causal_depthwise_conv(u, w, bias):
    c = u.shape[-1]
    y = lax.conv_general_dilated(u, w[:, None, :].astype(u.dtype), window_strides=(1,),
                                 padding=[(CONV_WIDTH - 1, 0)],
                                 dimension_numbers=('NWC', 'WIO', 'NWC'),
                                 feature_group_count=c)
    return y + bias.astype(u.dtype)


def rg_lru(u, w_a, b_a, w_x, b_x, lam):
    b, s, _ = u.shape
    uf = u.astype(jnp.float32)
    uh = uf.reshape(b, s, LRU_HEADS, LRU_HEAD_DIM)
    r = jax.nn.sigmoid(jnp.einsum('bshc,hcd->bshd', uh, w_a.astype(jnp.float32)).reshape(b, s, LRU_WIDTH)
                       + b_a.astype(jnp.float32))
    i = jax.nn.sigmoid(jnp.einsum('bshc,hcd->bshd', uh, w_x.astype(jnp.float32)).reshape(b, s, LRU_WIDTH)
                       + b_x.astype(jnp.float32))
    log_a = -LRU_C * r * jax.nn.softplus(-lam.astype(jnp.float32))
    a = jnp.exp(log_a)
    mult = jnp.sqrt(-jnp.expm1(2.0 * log_a))
    xin = mult * (i * uf)

    def combine(lhs, rhs):
        a1, b1 = lhs
        a2, b2 = rhs
        return a1 * a2, a2 * b1 + b2

    _, h = lax.associative_scan(combine, (a, xin), axis=1)
    return h


def pool_lru_mixer(x, w_in, w_pool, pool_scale, conv_w, conv_b, w_a, b_a, w_x, b_x, lam, w_out):
    proj = x @ w_in
    u_pool = proj[..., :POOL_WIDTH]
    u_lru = proj[..., POOL_WIDTH:POOL_WIDTH + LRU_WIDTH]
    u_gate = proj[..., POOL_WIDTH + LRU_WIDTH:]
    y_pool = multiscale_pool(u_pool, w_pool, pool_scale)
    h = rg_lru(causal_depthwise_conv(u_lru, conv_w, conv_b), w_a, b_a, w_x, b_x, lam)
    y_lru = (h * jax.nn.gelu(u_gate.astype(jnp.float32))).astype(x.dtype)
    return jnp.concatenate([y_pool, y_lru], axis=-1) @ w_out


def mla_mixer(x, cos, sin, w_down, q_norm_g, kv_norm_g, w_qb, w_kvb, w_o):
    b, s, _ = x.shape
    down = x @ w_down
    cq = rms_norm(down[..., :Q_LORA_RANK], q_norm_g)
    ckv = rms_norm(down[..., Q_LORA_RANK:Q_LORA_RANK + KV_LORA_RANK], kv_norm_g)
    k_pe = apply_rope(down[..., Q_LORA_RANK + KV_LORA_RANK:], cos, sin)
    q = (cq @ w_qb).reshape(b, s, MLA_HEADS, QK_NOPE_DIM + QK_ROPE_DIM)
    q_nope = q[..., :QK_NOPE_DIM]
    q_pe = apply_rope(q[..., QK_NOPE_DIM:], cos[:, :, None, :], sin[:, :, None, :])
    kv = (ckv @ w_kvb).reshape(b, s, MLA_HEADS, QK_NOPE_DIM + V_HEAD_DIM)
    k_nope = kv[..., :QK_NOPE_DIM]
    v = kv[..., QK_NOPE_DIM:]
    scale = (QK_NOPE_DIM + QK_ROPE_DIM) ** -0.5
    chunk_id = jnp.arange(s) // CHUNK
    neg = jnp.finfo(jnp.float32).min
    outs = []
    for qs in range(0, s, Q_BLOCK):
        ke = qs + Q_BLOCK
        sc = (jnp.einsum('bqhd,bkhd->bhqk', q_nope[:, qs:ke], k_nope[:, :ke],
                         preferred_element_type=jnp.float32)
              + jnp.einsum('bqhr,bkr->bhqk', q_pe[:, qs:ke], k_pe[:, :ke],
                           preferred_element_type=jnp.float32)) * scale
        mask = chunk_id[:ke][None, :] <= chunk_id[qs:ke][:, None]
        p = jax.nn.softmax(jnp.where(mask, sc, neg), axis=-1).astype(v.dtype)
        outs.append(jnp.einsum('bhqk,bkhv->bqhv', p, v[:, :ke]))
    o = jnp.concatenate(outs, axis=1).reshape(b, s, MLA_HEADS * V_HEAD_DIM)
    return o @ w_o


def squared_relu_mlp(x, w1, w2):
    return jnp.square(jax.nn.relu(x @ w1)) @ w2


def setup_inputs(seed: int = 0) -> dict:
    key = jax.random.key(seed)
    ks = jax.random.split(key, 28)
    f32 = jnp.float32
    nrm = lambda k, shp, sc: jax.random.normal(k, shp, f32) * sc
    x = jax.random.normal(ks[0], (BATCH, SEQ, D_MODEL), f32)
    offset = jax.random.randint(ks[1], (BATCH, 1), 0, 4096, dtype=jnp.int32)
    positions = (offset + jnp.arange(SEQ, dtype=jnp.int32)[None, :]).astype(jnp.int32)
    ln_mix_g = 1.0 + nrm(ks[2], (DEPTH, D_MODEL), 0.1)
    ln_mix_b = nrm(ks[3], (DEPTH, D_MODEL), 0.02)
    ln_ffn_g = 1.0 + nrm(ks[4], (DEPTH, D_MODEL), 0.1)
    ln_ffn_b = nrm(ks[5], (DEPTH, D_MODEL), 0.02)
    even_w_in = nrm(ks[6], (N_EVEN, D_MODEL, EVEN_IN_WIDTH), D_MODEL ** -0.5)
    pool_w = nrm(ks[7], (N_EVEN, POOL_GROUPS, POOL_GROUP_WIDTH, POOL_GROUP_WIDTH), POOL_GROUP_WIDTH ** -0.5)
    pool_scale = 1.0 + nrm(ks[8], (N_EVEN, POOL_WIDTH), 0.1)
    lru_conv_w = nrm(ks[9], (N_EVEN, CONV_WIDTH, LRU_WIDTH), CONV_WIDTH ** -0.5)
    lru_conv_b = nrm(ks[10], (N_EVEN, LRU_WIDTH), 0.02)
    lru_w_a = nrm(ks[11], (N_EVEN, LRU_HEADS, LRU_HEAD_DIM, LRU_HEAD_DIM), LRU_HEAD_DIM ** -0.5)
    lru_b_a = nrm(ks[12], (N_EVEN, LRU_WIDTH), 0.02)
    lru_w_x = nrm(ks[13], (N_EVEN, LRU_HEADS, LRU_HEAD_DIM, LRU_HEAD_DIM), LRU_HEAD_DIM ** -0.5)
    lru_b_x = nrm(ks[14], (N_EVEN, LRU_WIDTH), 0.02)
    a_c = jax.random.uniform(ks[15], (N_EVEN, LRU_WIDTH), f32, 0.9, 0.999)
    s_a = a_c ** (1.0 / LRU_C)
    lru_lambda = jnp.log(s_a) - jnp.log1p(-s_a)
    even_w_out = nrm(ks[16], (N_EVEN, EVEN_MIX_WIDTH, D_MODEL), EVEN_MIX_WIDTH ** -0.5 * DEEPNORM_BETA)
    mla_w_down = nrm(ks[17], (N_ODD, D_MODEL, ODD_IN_WIDTH), D_MODEL ** -0.5)
    mla_q_norm_g = 1.0 + nrm(ks[18], (N_ODD, Q_LORA_RANK), 0.1)
    mla_kv_norm_g = 1.0 + nrm(ks[19], (N_ODD, KV_LORA_RANK), 0.1)
    mla_w_qb = nrm(ks[20], (N_ODD, Q_LORA_RANK, MLA_HEADS * (QK_NOPE_DIM + QK_ROPE_DIM)), Q_LORA_RANK ** -0.5)
    mla_w_kvb = nrm(ks[21], (N_ODD, KV_LORA_RANK, MLA_HEADS * (QK_NOPE_DIM + V_HEAD_DIM)), KV_LORA_RANK ** -0.5)
    mla_w_o = nrm(ks[22], (N_ODD, MLA_HEADS * V_HEAD_DIM, D_MODEL), (MLA_HEADS * V_HEAD_DIM) ** -0.5 * DEEPNORM_BETA)
    mlp_w1 = nrm(ks[23], (DEPTH, D_MODEL, D_FF), D_MODEL ** -0.5)
    mlp_w2 = nrm(ks[24], (DEPTH, D_FF, D_MODEL), D_FF ** -0.5 * DEEPNORM_BETA)
    return {"x": x, "positions": positions,
            "ln_mix_g": ln_mix_g, "ln_mix_b": ln_mix_b, "ln_ffn_g": ln_ffn_g, "ln_ffn_b": ln_ffn_b,
            "even_w_in": even_w_in, "pool_w": pool_w, "pool_scale": pool_scale,
            "lru_conv_w": lru_conv_w, "lru_conv_b": lru_conv_b,
            "lru_w_a": lru_w_a, "lru_b_a": lru_b_a, "lru_w_x": lru_w_x, "lru_b_x": lru_b_x,
            "lru_lambda": lru_lambda, "even_w_out": even_w_out,
            "mla_w_down": mla_w_down, "mla_q_norm_g": mla_q_norm_g, "mla_kv_norm_g": mla_kv_norm_g,
            "mla_w_qb": mla_w_qb, "mla_w_kvb": mla_w_kvb, "mla_w_o": mla_w_o,
            "mlp_w1": mlp_w1, "mlp_w2": mlp_w2}


def reference(x, positions, ln_mix_g, ln_mix_b, ln_ffn_g, ln_ffn_b,
              even_w_in, pool_w, pool_scale, lru_conv_w, lru_conv_b,
              lru_w_a, lru_b_a, lru_w_x, lru_b_x, lru_lambda, even_w_out,
              mla_w_down, mla_q_norm_g, mla_kv_norm_g, mla_w_qb, mla_w_kvb, mla_w_o,
              mlp_w1, mlp_w2):
    cos, sin = rope_tables(positions)
    for layer in range(DEPTH):
        j = layer // 2
        if layer % 2 == 0:
            mix = pool_lru_mixer(x, even_w_in[j], pool_w[j], pool_scale[j],
                                 lru_conv_w[j], lru_conv_b[j], lru_w_a[j], lru_b_a[j],
                                 lru_w_x[j], lru_b_x[j], lru_lambda[j], even_w_out[j])
        else:
            mix = mla_mixer(x, cos, sin, mla_w_down[j], mla_q_norm_g[j], mla_kv_norm_g[j],
                            mla_w_qb[j], mla_w_kvb[j], mla_w_o[j])
        x = layer_norm(DEEPNORM_ALPHA * x + mix, ln_mix_g[layer], ln_mix_b[layer])
        x = layer_norm(DEEPNORM_ALPHA * x + squared_relu_mlp(x, mlp_w1[layer], mlp_w2[layer]),
                       ln_ffn_g[layer], ln_ffn_b[layer])
    return x
```

```cpp
#include <hip/hip_runtime.h>
#include <cstdio>
#include <cstdint>
#include <cmath>

#ifndef MK_ONE_LAUNCH
#define MK_ONE_LAUNCH 0
#endif
#ifndef USE_FAST_GEMM
#define USE_FAST_GEMM 0
#endif

#define LAS __attribute__((address_space(3)))
#define GAS __attribute__((address_space(1)))
typedef unsigned short bf16_t;
typedef short bf16x8 __attribute__((ext_vector_type(8)));
typedef float f32x4 __attribute__((ext_vector_type(4)));
typedef float f32x2 __attribute__((ext_vector_type(2)));
typedef float f32x16 __attribute__((ext_vector_type(16)));
typedef unsigned u32x4 __attribute__((ext_vector_type(4)));
typedef unsigned u32x2 __attribute__((ext_vector_type(2)));

constexpr int M = 16384, D = 1024, SEQ = 2048, NBATCH = 8, FF = 4096;
constexpr int POOLW = 512, LRUW = 1024, EVEN_IN = 2560, EVEN_MIX = 1536;
constexpr int QL = 384, KVL = 256, ROPE = 64, ODD_IN = 704, ODD_IN_PAD = 768;
constexpr int NH = 8, DQK = 192, DV = 128;
constexpr float ALPHA = 1.681792830507429f;
constexpr float LN_EPS = 1e-5f, RMS_EPS = 1e-6f;
constexpr float LOG2E = 1.4426950408889634f;
constexpr float QSCALE = 0.07216878364870322f * LOG2E;

constexpr size_t MiB = 1u << 20;
constexpr size_t WS_CTL = 0, CTL_ZERO_BYTES = 1 * MiB;
constexpr size_t WS_COS = 1 * MiB, WS_SIN = 3 * MiB;
constexpr size_t WS_CARRY = 5 * MiB;
constexpr size_t WS_SP = 7 * MiB;
constexpr size_t WS_W = 8 * MiB;
constexpr size_t WS_XB = 36 * MiB;
constexpr size_t WS_BIG = 68 * MiB;
constexpr size_t W_IN = 0, W_POOL = 5 * MiB, W_GATE = 5 * MiB + 256 * 1024, W_OUT = 6 * MiB + 256 * 1024;
constexpr size_t W_DOWN = 0, W_QB = 1 * MiB + 512 * 1024, W_KVB = 3 * MiB, W_O = 4 * MiB;
constexpr size_t W_1 = 10 * MiB, W_2 = 18 * MiB;
constexpr size_t B_P1 = 0, B_LOGA = 0, B_G = 48 * MiB, B_DU = 80 * MiB, B_XL = 128 * MiB;
constexpr size_t B_DOWN = 0, B_Q = 0, B_CQ = 48 * MiB, B_CKV = 60 * MiB, B_KPE = 68 * MiB, B_KN = 72 * MiB, B_V = 104 * MiB, B_O = 136 * MiB;
constexpr size_t B_H = 0;
constexpr size_t WS_END = 256 * MiB;
static_assert(WS_BIG + B_XL + (size_t)M * EVEN_MIX * 2 <= WS_END && WS_BIG + B_O + (size_t)M * D * 2 <= WS_END && WS_BIG + (size_t)M * FF * 2 <= WS_END, "ws map");

constexpr int CW_BAR = 4096;

constexpr int RING_BYTES = 131072;
constexpr int LDSCTL_OFF = RING_BYTES, MISC_OFF = LDSCTL_OFF + 320;
constexpr int LDS_BYTES = 147456;
constexpr int NWAVES = 8;

typedef __bf16 bf16x2_t __attribute__((ext_vector_type(2)));
__device__ __forceinline__ unsigned cvt_pk_bf16(float lo, float hi) { const f32x2 v = {lo, hi}; const bf16x2_t b = __builtin_convertvector(v, bf16x2_t); return __builtin_bit_cast(unsigned, b); }
__device__ __forceinline__ float bf2f(unsigned short u) { return __uint_as_float((unsigned)u << 16); }
__device__ __forceinline__ float bflo(unsigned u) { return __uint_as_float(u << 16); }
__device__ __forceinline__ float bfhi(unsigned u) { return __uint_as_float(u & 0xffff0000u); }
__device__ __forceinline__ u32x2 pack4(f32x4 v) { u32x2 w; w.x = cvt_pk_bf16(v[0], v[1]); w.y = cvt_pk_bf16(v[2], v[3]); return w; }
__device__ __forceinline__ float wave_sum(float v) {
#pragma unroll
    for (int o = 1; o < 64; o <<= 1) v += __shfl_xor(v, o);
    return v;
}
__device__ __forceinline__ float wave_max(float v) {
#pragma unroll
    for (int o = 1; o < 64; o <<= 1) v = fmaxf(v, __shfl_xor(v, o));
    return v;
}
__device__ __forceinline__ float sigmoidf_(float x) { return __builtin_amdgcn_rcpf(1.0f + __builtin_amdgcn_exp2f(-x * LOG2E)); }
__device__ __forceinline__ float gelu_tanh(float x) {
    const float u = 0.7978845608028654f * (x + 0.044715f * x * x * x);
    const float t = __builtin_amdgcn_exp2f(2.0f * LOG2E * u);
    const float th = 1.0f - 2.0f * __builtin_amdgcn_rcpf(t + 1.0f);
    return 0.5f * x * (1.0f + th);
}

struct Unit { int pm, pn; };
struct Gemm { const bf16_t* A; const bf16_t* Bt; int M, N, K, lda, ldb, ashift, amul; };

template <class Epi>
__device__ __forceinline__ void sgemm_phase(const Gemm g, const Epi& E) {
    const int tid = threadIdx.x, lane = tid & 63, wave = tid >> 6, r = lane & 31, hi = lane >> 5;
    const int nM = g.M / 256, nN = g.N / 256, nU = nM * nN;
    for (int u = blockIdx.x; u < nU; u += gridDim.x) {
        const int pm = u / nN, pn = u % nN;
        const bf16_t* A = g.A + (size_t)(pm * 256 + wave * 32 + r) * g.lda + (size_t)((pn >> g.ashift) * g.amul) + 8 * hi;
        const bf16_t* B = g.Bt + (size_t)(pn * 256 + r) * g.ldb + 8 * hi;
        for (int cb = 0; cb < 4; ++cb) {
            f32x16 acc0 = {}, acc1 = {};
            const bf16_t* B0 = B + (size_t)(cb * 32) * g.ldb;
            const bf16_t* B1 = B0 + (size_t)128 * g.ldb;
            for (int k0 = 0; k0 < g.K; k0 += 16) {
                const bf16x8 a = *(const bf16x8*)(A + k0);
                const bf16x8 b0 = *(const bf16x8*)(B0 + k0);
                const bf16x8 b1 = *(const bf16x8*)(B1 + k0);
                acc0 = __builtin_amdgcn_mfma_f32_32x32x16_bf16(b0, a, acc0, 0, 0, 0);
                acc1 = __builtin_amdgcn_mfma_f32_32x32x16_bf16(b1, a, acc1, 0, 0, 0);
            }
            const int row = pm * 256 + wave * 32 + r;
#pragma unroll
            for (int q = 0; q < 4; ++q) {
                const f32x4 v0 = {acc0[4 * q], acc0[4 * q + 1], acc0[4 * q + 2], acc0[4 * q + 3]};
                const f32x4 v1 = {acc1[4 * q], acc1[4 * q + 1], acc1[4 * q + 2], acc1[4 * q + 3]};
                E(row, pn, cb * 32 + 8 * q + 4 * hi, v0, v1);
            }
        }
    }
}

struct EpiIn {
    bf16_t* P1; bf16_t* G;
    __device__ __forceinline__ void operator()(int row, int pn, int cc, f32x4 v0, f32x4 v1) const {
        if (pn < 6) { bf16_t* p = P1 + (size_t)row * EVEN_MIX + pn * 256 + cc; *(u32x2*)p = pack4(v0); *(u32x2*)(p + 128) = pack4(v1); }
        else { bf16_t* p = G + (size_t)row * LRUW + (pn - 6) * 256 + cc;
#pragma unroll
            for (int e = 0; e < 4; ++e) { v0[e] = gelu_tanh(v0[e]); v1[e] = gelu_tanh(v1[e]); }
            *(u32x2*)p = pack4(v0); *(u32x2*)(p + 128) = pack4(v1); }
    }
};
struct EpiPool {
    bf16_t* XL; const float* scale;
    __device__ __forceinline__ void operator()(int row, int pn, int cc, f32x4 v0, f32x4 v1) const {
        const int c = pn * 256 + cc; const f32x4 s0 = *(const f32x4*)(scale + c), s1 = *(const f32x4*)(scale + c + 128);
        bf16_t* p = XL + (size_t)row * EVEN_MIX + c; *(u32x2*)p = pack4(v0 * s0); *(u32x2*)(p + 128) = pack4(v1 * s1);
    }
};
struct EpiGate {
    const bf16_t* DU; bf16_t* LOGA; bf16_t* XL; const float* b_a; const float* b_x; const float* sp8;
    __device__ __forceinline__ void operator()(int row, int pn, int cc, f32x4 v0, f32x4 v1) const {
        const int ch = pn * 128 + cc;
        const f32x4 ba = *(const f32x4*)(b_a + ch), bx = *(const f32x4*)(b_x + ch), sp = *(const f32x4*)(sp8 + ch);
        const u32x2 uu = *(const u32x2*)(DU + (size_t)row * EVEN_MIX + POOLW + ch);
        const float uf[4] = {bflo(uu.x), bfhi(uu.x), bflo(uu.y), bfhi(uu.y)};
        f32x4 la, xi;
#pragma unroll
        for (int e = 0; e < 4; ++e) {
            const float rg = sigmoidf_(v0[e] + ba[e]), ig = sigmoidf_(v1[e] + bx[e]);
            const float log_a = rg * sp[e];
            const float mult = sqrtf(fmaxf(-expm1f(2.0f * log_a), 0.0f));
            la[e] = log_a * LOG2E; xi[e] = mult * (ig * uf[e]);
        }
        *(u32x2*)(LOGA + (size_t)row * LRUW + ch) = pack4(la);
        *(u32x2*)(XL + (size_t)row * EVEN_MIX + POOLW + ch) = pack4(xi);
    }
};
struct EpiRes {
    const float* res; float* out;
    __device__ __forceinline__ void operator()(int row, int pn, int cc, f32x4 v0, f32x4 v1) const {
        const size_t o = (size_t)row * D + pn * 256 + cc;
        const f32x4 r0 = *(const f32x4*)(res + o), r1 = *(const f32x4*)(res + o + 128);
        *(f32x4*)(out + o) = r0 * ALPHA + v0; *(f32x4*)(out + o + 128) = r1 * ALPHA + v1;
    }
};
struct EpiRelu2 {
    bf16_t* H;
    __device__ __forceinline__ void operator()(int row, int pn, int cc, f32x4 v0, f32x4 v1) const {
#pragma unroll
        for (int e = 0; e < 4; ++e) { const float a = fmaxf(v0[e], 0.f), b = fmaxf(v1[e], 0.f); v0[e] = a * a; v1[e] = b * b; }
        bf16_t* p = H + (size_t)row * FF + pn * 256 + cc; *(u32x2*)p = pack4(v0); *(u32x2*)(p + 128) = pack4(v1);
    }
};
struct EpiDown {
    float* DOWN;
    __device__ __forceinline__ void operator()(int row, int pn, int cc, f32x4 v0, f32x4 v1) const {
        float* p = DOWN + (size_t)row * ODD_IN_PAD + pn * 256 + cc; *(f32x4*)p = v0; *(f32x4*)(p + 128) = v1;
    }
};
struct EpiQ {
    bf16_t* Q; const float* COS; const float* SIN;
    __device__ __forceinline__ void operator()(int row, int pn, int cc, f32x4 v0, f32x4 v1) const {
        bf16_t* qr = Q + (size_t)row * (NH * DQK);
        if (pn < 4) { *(u32x2*)(qr + (2 * pn) * DQK + cc) = pack4(v0 * QSCALE); *(u32x2*)(qr + (2 * pn + 1) * DQK + cc) = pack4(v1 * QSCALE); }
        else { const int h = 4 * (pn - 4) + (cc >> 5), i = cc & 31;
            const f32x4 c = *(const f32x4*)(COS + (size_t)row * 32 + i), s = *(const f32x4*)(SIN + (size_t)row * 32 + i);
            const f32x4 o1 = (v0 * c - v1 * s) * QSCALE, o2 = (v0 * s + v1 * c) * QSCALE;
            *(u32x2*)(qr + h * DQK + 128 + i) = pack4(o1); *(u32x2*)(qr + h * DQK + 160 + i) = pack4(o2); }
    }
};
struct EpiKV {
    bf16_t* KN; bf16_t* V;
    __device__ __forceinline__ void operator()(int row, int pn, int cc, f32x4 v0, f32x4 v1) const {
        bf16_t* p = (pn < 4 ? KN : V) + (size_t)row * D + (pn & 3) * 256 + cc; *(u32x2*)p = pack4(v0); *(u32x2*)(p + 128) = pack4(v1);
    }
};

namespace pg8 {
constexpr int BM = 256, BK = 64, HALF = 128, HTB = HALF * BK * 2, STAGE_BYTES = 8 * HTB, NXCD = 8, WGM = 8;
__host__ __device__ __forceinline__ int lds_byte(int r, int c) { const int st = (r >> 4) * 2 + (c >> 5), rr = r & 15, cc = c & 31, ob = rr * 64 + cc * 2; return st * 1024 + (ob ^ (((ob >> 9) & 1) << 5)); }
__host__ __device__ __forceinline__ void stage_rc(int b, int& R, int& C) { const int st = b / 1024, sb = b % 1024, swz = sb ^ (((sb >> 9) & 1) << 5); R = (st >> 1) * 16 + swz / 64; C = (st & 1) * 32 + (swz % 64) / 2; }
struct StaticOrder {
    int nM, nN, nwg, G, c;
    __device__ void init(int M_, int N_, int G_, int c_) { nM = M_ / BM; nN = N_ / BM; nwg = nM * nN; G = G_; c = c_; }
    __device__ bool next(int i, Unit& u) const {
        const long L = (long)i * G + c; if (L >= nwg) return false;
        int wgid = (int)L; { const int q = nwg / NXCD, r = nwg % NXCD, xcd = wgid % NXCD, off = wgid / NXCD; wgid = (xcd < r ? xcd * (q + 1) : r * (q + 1) + (xcd - r) * q) + off; }
        const int nig = WGM * nN, gid = wgid / nig, fm = gid * WGM, gsz = (nM - fm) < WGM ? (nM - fm) : WGM;
        u.pm = fm + ((wgid % nig) % gsz); u.pn = (wgid % nig) / gsz; return true;
    }
};
template <class Epi>
__device__ __forceinline__ void gemm_phase(LAS unsigned char* lds, const Gemm g, const StaticOrder& S, const Epi& E) {
    const int tid = threadIdx.x, wid = __builtin_amdgcn_readfirstlane(tid >> 6), lane = tid & 63, wr = wid >> 2, wc = wid & 3, fr = lane & 15, fq = lane >> 4;
    const int K = g.K, nt = K / BK;
    unsigned voffA[2], voffB[2];
#pragma unroll
    for (int i = 0; i < 2; ++i) { int R, C; stage_rc(tid * 16 + i * 8192, R, C); voffA[i] = (unsigned)(R * g.lda + C) * 2u; voffB[i] = (unsigned)(R * g.ldb + C) * 2u; }
    const size_t kstep = (size_t)(BK * 2);
    const size_t hstepA = (size_t)HALF * g.lda * 2, hstepB = (size_t)HALF * g.ldb * 2;
    const size_t tstepA = 2 * hstepA, tstepB = 2 * hstepB;
    const unsigned ldsw = (unsigned)wid * 1024u;
    const int aoff = lds_byte(wr * 64 + fr, fq * 8), boff = lds_byte(wc * 32 + fr, fq * 8);
#define PG8_SA(b, h) (((b) * 2 + (h)) * HTB)
#define PG8_SB(b, h) ((4 + (b) * 2 + (h)) * HTB)
#define PG8_STAGE(bufoff, gbase, voff) do { _Pragma("unroll") for (int _i = 0; _i < 2; ++_i) \
        __builtin_amdgcn_global_load_lds((const unsigned*)((const char*)(gbase) + (voff)[_i]), (LAS unsigned*)(lds + (bufoff) + ldsw + _i * 8192), 16, 0, 0); } while (0)
#define PG8_LDA(dst, b, h) do { _Pragma("unroll") for (int m = 0; m < 4; ++m) _Pragma("unroll") for (int k = 0; k < 2; ++k) dst[m][k] = *(const LAS bf16x8*)(lds + PG8_SA(b, h) + aoff + m * 2048 + k * 1024); } while (0)
#define PG8_LDB(dst, b, h) do { _Pragma("unroll") for (int n = 0; n < 2; ++n) _Pragma("unroll") for (int k = 0; k < 2; ++k) dst[n][k] = *(const LAS bf16x8*)(lds + PG8_SB(b, h) + boff + n * 2048 + k * 1024); } while (0)
#define PG8_MMA(ai, bj, At, Bt) do { __builtin_amdgcn_s_setprio(1); _Pragma("unroll") for (int m = 0; m < 4; ++m) _Pragma("unroll") for (int n = 0; n < 2; ++n) _Pragma("unroll") for (int k = 0; k < 2; ++k) \
        acc[ai][bj][m][n] = __builtin_amdgcn_mfma_f32_16x16x32_bf16(Bt[n][k], At[m][k], acc[ai][bj][m][n], 0, 0, 0); __builtin_amdgcn_s_setprio(0); } while (0)
#define PG8_WAIT_V(n) asm volatile("s_waitcnt vmcnt(" #n ")" ::: "memory")
#define PG8_WAIT_L(n) asm volatile("s_waitcnt lgkmcnt(" #n ")" ::: "memory")
#define PG8_BAR __builtin_amdgcn_s_barrier()
#define PG8_SCHED __builtin_amdgcn_sched_barrier(0)
#define PG8_APTR(u) ((const char*)g.A + (size_t)(u).pm * tstepA + (size_t)(((u).pn >> g.ashift) * g.amul) * 2)
#define PG8_BPTR(u) ((const char*)g.Bt + (size_t)(u).pn * tstepB)
    Unit cur, nxt; int ui = 0;
    if (!S.next(0, cur)) return;
    f32x4 acc[2][2][4][2];
#pragma unroll
    for (int a = 0; a < 2; ++a)
#pragma unroll
        for (int b = 0; b < 2; ++b)
#pragma unroll
            for (int m = 0; m < 4; ++m)
#pragma unroll
                for (int n = 0; n < 2; ++n) acc[a][b][m][n] = (f32x4){0.f, 0.f, 0.f, 0.f};
    bf16x8 At[4][2], B0[2][2], B1[2][2];
    const char* cA = PG8_APTR(cur); const char* cB = PG8_BPTR(cur);
    PG8_STAGE(PG8_SB(0, 0), cB, voffB); PG8_STAGE(PG8_SB(0, 1), cB + hstepB, voffB); PG8_STAGE(PG8_SA(0, 0), cA, voffA); PG8_STAGE(PG8_SA(0, 1), cA + hstepA, voffA);
    if (wr == 1) PG8_BAR;
    PG8_WAIT_V(2); PG8_BAR;
    PG8_STAGE(PG8_SB(1, 0), cB + kstep, voffB); PG8_STAGE(PG8_SA(1, 0), cA + kstep, voffA); PG8_STAGE(PG8_SB(1, 1), cB + hstepB + kstep, voffB);
    PG8_WAIT_V(6); PG8_BAR;
    for (;;) {
        const bool has_next = S.next(ui + 1, nxt);
        const char* nA = has_next ? PG8_APTR(nxt) : cA; const char* nB = has_next ? PG8_BPTR(nxt) : cB;
        for (int t = 0; t < nt; t += 2) {
            const bool last = (t == nt - 2);
            const char* a1 = cA + (size_t)(t + 1) * kstep;
            const char* a2 = last ? nA : cA + (size_t)(t + 2) * kstep; const char* b2 = last ? nB : cB + (size_t)(t + 2) * kstep;
            const char* a3 = a2 + kstep; const char* b3 = b2 + kstep;
            PG8_LDB(B0, 0, 0); PG8_LDB(B1, 0, 1); PG8_SCHED; PG8_LDA(At, 0, 0); PG8_STAGE(PG8_SA(1, 1), a1 + hstepA, voffA);
            PG8_WAIT_V(8); PG8_WAIT_L(0); PG8_BAR; PG8_MMA(0, 0, At, B0); PG8_MMA(0, 1, At, B1); PG8_BAR; PG8_SCHED;
            PG8_LDA(At, 0, 1); PG8_STAGE(PG8_SB(0, 0), b2, voffB); PG8_STAGE(PG8_SB(0, 1), b2 + hstepB, voffB); PG8_STAGE(PG8_SA(0, 0), a2, voffA);
            PG8_WAIT_V(8); PG8_WAIT_L(0); PG8_BAR; PG8_MMA(1, 0, At, B0); PG8_MMA(1, 1, At, B1); PG8_BAR; PG8_SCHED;
            PG8_LDB(B0, 1, 0); PG8_LDB(B1, 1, 1); PG8_SCHED; PG8_LDA(At, 1, 0); PG8_STAGE(PG8_SA(0, 1), a2 + hstepA, voffA);
            PG8_WAIT_V(8); PG8_WAIT_L(0); PG8_BAR; PG8_MMA(0, 0, At, B0); PG8_MMA(0, 1, At, B1); PG8_BAR; PG8_SCHED;
            PG8_LDA(At, 1, 1); PG8_STAGE(PG8_SB(1, 0), b3, voffB); PG8_STAGE(PG8_SB(1, 1), b3 + hstepB, voffB); PG8_STAGE(PG8_SA(1, 0), a3, voffA);
            PG8_WAIT_V(8); PG8_WAIT_L(0); PG8_BAR; PG8_MMA(1, 0, At, B0); PG8_MMA(1, 1, At, B1); PG8_BAR; PG8_SCHED;
        }
        if (wr == 0) PG8_BAR;
        {
#pragma unroll
            for (int ai = 0; ai < 2; ++ai)
#pragma unroll
                for (int m = 0; m < 4; ++m) { const int row = cur.pm * BM + ai * HALF + wr * 64 + m * 16 + fr;
#pragma unroll
                    for (int n = 0; n < 2; ++n) E(row, cur.pn, wc * 32 + n * 16 + 4 * fq, acc[ai][0][m][n], acc[ai][1][m][n]); }
        }
        if (!has_next) break;
#pragma unroll
        for (int a = 0; a < 2; ++a)
#pragma unroll
            for (int b = 0; b < 2; ++b)
#pragma unroll
                for (int m = 0; m < 4; ++m)
#pragma unroll
                    for (int n = 0; n < 2; ++n) acc[a][b][m][n] = (f32x4){0.f, 0.f, 0.f, 0.f};
        cur = nxt; cA = nA; cB = nB; ++ui;
        if (wr == 1) PG8_BAR;
    }
    PG8_WAIT_V(0);
    PG8_BAR;
#undef PG8_SA
#undef PG8_SB
#undef PG8_STAGE
#undef PG8_LDA
#undef PG8_LDB
#undef PG8_MMA
#undef PG8_WAIT_V
#undef PG8_WAIT_L
#undef PG8_BAR
#undef PG8_SCHED
#undef PG8_APTR
#undef PG8_BPTR
}
}

#define XB_TMO      128
#define XB_XCNT(j)  (256  + 64 * (j))
#define XB_XSUB(j)  (1280 + 64 * (j))
#define XB_XGEN(j)  (2304 + 64 * (j))
#define XB_TOP      3328
#define XB_TOPGEN   3392
#define XCD_BAR_WORDS 3456
#define XB_SPIN_CAP (1u << 18)
__device__ __forceinline__ unsigned xb_ld(unsigned* p)              { return __hip_atomic_load(p, __ATOMIC_RELAXED, __HIP_MEMORY_SCOPE_AGENT); }
__device__ __forceinline__ unsigned xb_add(unsigned* p, unsigned v) { return __hip_atomic_fetch_add(p, v, __ATOMIC_RELAXED, __HIP_MEMORY_SCOPE_AGENT); }
__device__ __forceinline__ unsigned xb_xcc_id() { return (unsigned)__builtin_amdgcn_s_getreg((3 << 11) | 20) & 0xFu; }
#define XB_SPIN(cond, bar) do { unsigned _sp = 0; while (cond) { __builtin_amdgcn_s_sleep(1); \
    if ((++_sp & 255u) == 0u) { if (xb_ld(&(bar)[XB_TMO])) break; if (_sp > XB_SPIN_CAP) { atomicAdd(&(bar)[XB_TMO], 1u); break; } } } } while (0)
struct XcdBarrier { unsigned* bar; unsigned x; volatile LAS unsigned* st; };
__device__ __forceinline__ XcdBarrier xcd_barrier_post(unsigned* bar, volatile LAS unsigned* st) {
    XcdBarrier b; b.bar = bar; b.x = xb_xcc_id(); b.st = st;
    if (threadIdx.x == 0) (void)xb_add(&bar[XB_XCNT(b.x)], 1u);
    return b;
}
__device__ __forceinline__ void xcd_barrier_complete(unsigned* bar, unsigned x, unsigned& nloc, unsigned& nx) {
    const unsigned G = gridDim.x * gridDim.y * gridDim.z;
    unsigned sum, cnt, mine, sp = 0u;
    for (;;) {
        sum = 0u; cnt = 0u; mine = 0u;
#pragma unroll
        for (unsigned j = 0; j < 16; ++j) { const unsigned c = xb_ld(&bar[XB_XCNT(j)]); sum += c; cnt += (c > 0u) ? 1u : 0u; mine = (j == x) ? c : mine; }
        if (sum == G) break;
        __builtin_amdgcn_s_sleep(1);
        if ((++sp & 255u) == 0u) { if (xb_ld(&bar[XB_TMO])) break; if (sp > XB_SPIN_CAP) { atomicAdd(&bar[XB_TMO], 1u); break; } }
    }
    nloc = mine > 0u ? mine : 1u; nx = cnt > 0u ? cnt : 1u;
}
__device__ __forceinline__ void xcd_barrier(const XcdBarrier& b) {
    asm volatile("s_waitcnt vmcnt(0)" ::: "memory");
    __syncthreads();
    if (threadIdx.x == 0) {
        unsigned* bar = b.bar;
        __builtin_amdgcn_s_waitcnt(0);
        unsigned nloc = b.st[0], nx = b.st[1];
        if (nloc == 0u) { xcd_barrier_complete(bar, b.x, nloc, nx); b.st[0] = nloc; b.st[1] = nx; }
        const unsigned old = xb_add(&bar[XB_XSUB(b.x)], 1u);
        const unsigned gen = old / nloc;
        if (old + 1u == (gen + 1u) * nloc) {
            __builtin_amdgcn_fence(__ATOMIC_RELEASE, "agent");
            asm volatile("s_waitcnt vmcnt(0)" ::: "memory");
            const unsigned og = xb_add(&bar[XB_TOP], 1u);
            const unsigned tg = og / nx;
            if (og + 1u == (tg + 1u) * nx) xb_add(&bar[XB_TOPGEN], 1u);
            else XB_SPIN(xb_ld(&bar[XB_TOPGEN]) == tg, bar);
            __builtin_amdgcn_fence(__ATOMIC_ACQUIRE, "agent");
            xb_add(&bar[XB_XGEN(b.x)], 1u);
            asm volatile("s_waitcnt vmcnt(0)" ::: "memory");
        } else {
            XB_SPIN(xb_ld(&bar[XB_XGEN(b.x)]) == gen, bar);
            __builtin_amdgcn_fence(__ATOMIC_ACQUIRE, "agent");
            asm volatile("s_waitcnt vmcnt(0)" ::: "memory");
        }
    }
    __syncthreads();
}

struct Args {
    const float* in[25];
    float* out; unsigned char* ws;
    int ph_lo, ph_hi;
};
enum { I_X = 0, I_POS, I_LNMG, I_LNMB, I_LNFG, I_LNFB, I_EWIN, I_POOLW, I_POOLS, I_CONVW, I_CONVB, I_WA, I_BA, I_WX, I_BX, I_LAM, I_EWOUT,
       I_WDOWN, I_QNG, I_KVNG, I_WQB, I_WKVB, I_WO, I_W1, I_W2 };

__device__ __forceinline__ void transpose_item(const float* src, int ld_src, int src_row0, int src_col0, bf16_t* dst, int ld_dst, int dst_row0, int dst_col0, bool zero, float* scr, int lane) {
    if (!zero) {
#pragma unroll 8
        for (int i = 0; i < 32; ++i) { const int kk = 2 * i + (lane >> 5); scr[kk * 33 + (lane & 31)] = src[(size_t)(src_row0 + kk) * ld_src + src_col0 + (lane & 31)]; }
    }
    asm volatile("s_waitcnt lgkmcnt(0)" ::: "memory");
    const int c = lane & 7;
#pragma unroll
    for (int j = 0; j < 4; ++j) { const int n = (lane >> 3) + 8 * j; const float* s = scr + (8 * c) * 33 + n;
        u32x4 o = {0u, 0u, 0u, 0u};
        if (!zero) { o.x = cvt_pk_bf16(s[0 * 33], s[1 * 33]); o.y = cvt_pk_bf16(s[2 * 33], s[3 * 33]); o.z = cvt_pk_bf16(s[4 * 33], s[5 * 33]); o.w = cvt_pk_bf16(s[6 * 33], s[7 * 33]); }
        *(u32x4*)(dst + (size_t)(dst_row0 + n) * ld_dst + dst_col0 + 8 * c) = o; }
    asm volatile("s_waitcnt lgkmcnt(0)" ::: "memory");
}
__device__ __forceinline__ void conv_plain(const float* src, int K, int N, int Npad, bf16_t* dst, float* scr, int gw, int NGW, int lane) {
    const int nblk = Npad / 32, items = (K / 64) * nblk;
    for (int it = gw; it < items; it += NGW) { const int kb = it / nblk, nb = it % nblk;
        transpose_item(src, N, 64 * kb, 32 * nb, dst, K, 32 * nb, 64 * kb, 32 * nb >= N, scr, lane); }
}
__device__ __forceinline__ void convert_weights(const Args& a, int layer, float* scr, int gw, int NGW, int lane) {
    unsigned char* W = a.ws + WS_W; const int j = layer >> 1;
    if ((layer & 1) == 0) {
        conv_plain(a.in[I_EWIN] + (size_t)j * D * EVEN_IN, D, EVEN_IN, EVEN_IN, (bf16_t*)(W + W_IN), scr, gw, NGW, lane);
        conv_plain(a.in[I_EWOUT] + (size_t)j * EVEN_MIX * D, EVEN_MIX, D, D, (bf16_t*)(W + W_OUT), scr, gw, NGW, lane);
        {
            const float* pw = a.in[I_POOLW] + (size_t)j * 4 * 128 * 128; bf16_t* dst = (bf16_t*)(W + W_POOL);
            for (int it = gw; it < 16 * 4; it += NGW) { const int nb = it >> 2, kb = it & 3, g = nb >> 2; const bool nz = (kb >> 1) == (g & 1);
                transpose_item(pw + (size_t)g * 128 * 128, 128, 64 * (kb & 1), 32 * (nb & 3), dst, 256, 32 * nb, 64 * kb, !nz, scr, lane); }
        }
        {
            const float* wa = a.in[I_WA] + (size_t)j * 8 * 128 * 128; const float* wx = a.in[I_WX] + (size_t)j * 8 * 128 * 128; bf16_t* dst = (bf16_t*)(W + W_GATE);
            for (int it = gw; it < 64 * 4; it += NGW) { const int nb = it >> 2, kb = it & 3, h = nb >> 3, half = (nb >> 2) & 1; const bool nz = (kb >> 1) == (h & 1);
                transpose_item((half ? wx : wa) + (size_t)h * 128 * 128, 128, 64 * (kb & 1), 32 * (nb & 3), dst, 256, 32 * nb, 64 * kb, !nz, scr, lane); }
        }
        {
            float* sp = (float*)(a.ws + WS_SP); const float* lam = a.in[I_LAM] + (size_t)j * LRUW;
            for (int i = gw * 64 + lane; i < LRUW; i += NGW * 64) { const float l = lam[i]; sp[i] = -8.0f * (l > 15.f ? expf(-l) : log1pf(expf(-l))); }
        }
    } else {
        conv_plain(a.in[I_WDOWN] + (size_t)j * D * ODD_IN, D, ODD_IN, ODD_IN_PAD, (bf16_t*)(W + W_DOWN), scr, gw, NGW, lane);
        conv_plain(a.in[I_WO] + (size_t)j * D * D, D, D, D, (bf16_t*)(W + W_O), scr, gw, NGW, lane);
        {
            const float* wq = a.in[I_WQB] + (size_t)j * QL * (NH * DQK); bf16_t* dst = (bf16_t*)(W + W_QB);
            for (int it = gw; it < 6 * 48; it += NGW) { const int kb = it / 48, nb = it % 48, n0 = 32 * nb; int sc;
                if (n0 < 1024) sc = (n0 >> 7) * DQK + (n0 & 127);
                else { const int m = n0 - 1024, p = m >> 8, half = (m >> 7) & 1, hl = (m >> 5) & 3; sc = (4 * p + hl) * DQK + 128 + half * 32; }
                transpose_item(wq, NH * DQK, 64 * kb, sc, dst, QL, n0, 64 * kb, false, scr, lane); }
        }
        {
            const float* wkv = a.in[I_WKVB] + (size_t)j * KVL * (NH * 256); bf16_t* dst = (bf16_t*)(W + W_KVB);
            for (int it = gw; it < 4 * 64; it += NGW) { const int kb = it / 64, nb = it % 64, n0 = 32 * nb; const int m = n0 & 1023;
                const int sc = (m >> 7) * 256 + (n0 >= 1024 ? 128 : 0) + (m & 127);
                transpose_item(wkv, NH * 256, 64 * kb, sc, dst, KVL, n0, 64 * kb, false, scr, lane); }
        }
    }
    conv_plain(a.in[I_W1] + (size_t)layer * D * FF, D, FF, FF, (bf16_t*)(W + W_1), scr, gw, NGW, lane);
    conv_plain(a.in[I_W2] + (size_t)layer * FF * D, FF, D, D, (bf16_t*)(W + W_2), scr, gw, NGW, lane);
}

__device__ __forceinline__ void ln_row(float* xrow, bf16_t* brow, const float* g, const float* b, int lane) {
    f32x4 v[4]; float s = 0.f;
#pragma unroll
    for (int j = 0; j < 4; ++j) { v[j] = *(const f32x4*)(xrow + 4 * lane + 256 * j); s += (v[j][0] + v[j][1]) + (v[j][2] + v[j][3]); }
    const float mean = wave_sum(s) * (1.f / D); float s2 = 0.f;
#pragma unroll
    for (int j = 0; j < 4; ++j) { v[j] = v[j] - mean; s2 += (v[j][0] * v[j][0] + v[j][1] * v[j][1]) + (v[j][2] * v[j][2] + v[j][3] * v[j][3]); }
    const float rstd = 1.0f / sqrtf(wave_sum(s2) * (1.f / D) + LN_EPS);
#pragma unroll
    for (int j = 0; j < 4; ++j) { const f32x4 gg = *(const f32x4*)(g + 4 * lane + 256 * j), bb = *(const f32x4*)(b + 4 * lane + 256 * j);
        const f32x4 o = v[j] * rstd * gg + bb; *(f32x4*)(xrow + 4 * lane + 256 * j) = o; *(u32x2*)(brow + 4 * lane + 256 * j) = pack4(o); }
}
__device__ __forceinline__ void ln_phase(const Args& a, const float* g, const float* b, int gw, int NGW, int lane) {
    bf16_t* XB = (bf16_t*)(a.ws + WS_XB);
    for (int m = gw; m < M; m += NGW) ln_row(a.out + (size_t)m * D, XB + (size_t)m * D, g, b, lane);
}
__device__ __forceinline__ void prologue_phase(const Args& a, int gw, int NGW, int lane) {
    bf16_t* XB = (bf16_t*)(a.ws + WS_XB); const float* x = a.in[I_X];
    for (int m = gw; m < M; m += NGW) {
#pragma unroll
        for (int j = 0; j < 4; ++j) { const f32x4 v = *(const f32x4*)(x + (size_t)m * D + 4 * lane + 256 * j); *(u32x2*)(XB + (size_t)m * D + 4 * lane + 256 * j) = pack4(v); }
    }
    float* COS = (float*)(a.ws + WS_COS); float* SIN = (float*)(a.ws + WS_SIN); const int* pos = (const int*)a.in[I_POS];
    for (int i = gw * 64 + lane; i < M * 32; i += NGW * 64) { const int m = i >> 5, f = i & 31;
        const float inv = powf(10000.0f, -(float)(2 * f) / 64.0f); const float ang = (float)pos[m] * inv;
        COS[i] = cosf(ang); SIN[i] = sinf(ang); }
}
__device__ __forceinline__ void convpool_phase(const Args& a, int layer) {
    const int j = layer >> 1;
    const bf16_t* P1 = (const bf16_t*)(a.ws + WS_BIG + B_P1); bf16_t* DU = (bf16_t*)(a.ws + WS_BIG + B_DU);
    const float* cw = a.in[I_CONVW] + (size_t)j * 4 * LRUW; const float* cb = a.in[I_CONVB] + (size_t)j * LRUW;
    const int nitems = M * 192;
    for (int it = blockIdx.x * 512 + threadIdx.x; it < nitems; it += gridDim.x * 512) {
        const int m = it / 192, c8 = it % 192, t = m & (SEQ - 1);
        float o[8];
        if (c8 < 64) {
            const int c = 8 * c8, w = 2 << (c8 >> 4), n = (t + 1 < w) ? (t + 1) : w;
            float s[8], cur[8];
#pragma unroll
            for (int e = 0; e < 8; ++e) s[e] = 0.f;
            for (int k = 0; k < n; ++k) { const u32x4 v = *(const u32x4*)(P1 + (size_t)(m - k) * EVEN_MIX + c);
                const float f[8] = {bflo(v.x), bfhi(v.x), bflo(v.y), bfhi(v.y), bflo(v.z), bfhi(v.z), bflo(v.w), bfhi(v.w)};
#pragma unroll
                for (int e = 0; e < 8; ++e) { s[e] += f[e]; if (k == 0) cur[e] = f[e]; } }
            const float inv = 1.0f / (float)n;
#pragma unroll
            for (int e = 0; e < 8; ++e) o[e] = s[e] * inv - cur[e];
            u32x4 w4; w4.x = cvt_pk_bf16(o[0], o[1]); w4.y = cvt_pk_bf16(o[2], o[3]); w4.z = cvt_pk_bf16(o[4], o[5]); w4.w = cvt_pk_bf16(o[6], o[7]);
            *(u32x4*)(DU + (size_t)m * EVEN_MIX + c) = w4;
        } else {
            const int ch = 8 * (c8 - 64);
#pragma unroll
            for (int e = 0; e < 8; ++e) o[e] = cb[ch + e];
#pragma unroll
            for (int k = 0; k < 4; ++k) { const int dt = 3 - k; if (t - dt >= 0) {
                const u32x4 v = *(const u32x4*)(P1 + (size_t)(m - dt) * EVEN_MIX + POOLW + ch);
                const float f[8] = {bflo(v.x), bfhi(v.x), bflo(v.y), bfhi(v.y), bflo(v.z), bfhi(v.z), bflo(v.w), bfhi(v.w)};
#pragma unroll
                for (int e = 0; e < 8; ++e) o[e] += cw[k * LRUW + ch + e] * f[e]; } }
            u32x4 w4; w4.x = cvt_pk_bf16(o[0], o[1]); w4.y = cvt_pk_bf16(o[2], o[3]); w4.z = cvt_pk_bf16(o[4], o[5]); w4.w = cvt_pk_bf16(o[6], o[7]);
            *(u32x4*)(DU + (size_t)m * EVEN_MIX + POOLW + ch) = w4;
        }
    }
}
constexpr int SC_NCH = 32, SC_LEN = 64;
__device__ __forceinline__ void scan_phase(const Args& a, int pass) {
    const bf16_t* LOGA = (const bf16_t*)(a.ws + WS_BIG + B_LOGA); bf16_t* XL = (bf16_t*)(a.ws + WS_BIG + B_XL); const bf16_t* G = (const bf16_t*)(a.ws + WS_BIG + B_G);
    float* CA = (float*)(a.ws + WS_CARRY); float* CH = (float*)(a.ws + WS_CARRY + 1 * MiB);
    const int nitems = NBATCH * SC_NCH * (LRUW / 2);
    for (int it = blockIdx.x * 512 + threadIdx.x; it < nitems; it += gridDim.x * 512) {
        const int c2 = it % (LRUW / 2), chunk = (it / (LRUW / 2)) % SC_NCH, b = it / ((LRUW / 2) * SC_NCH), ch = 2 * c2;
        const size_t m0 = (size_t)b * SEQ + (size_t)chunk * SC_LEN;
        float h0 = 0.f, h1 = 0.f;
        if (pass == 1) {
            float A0 = 1.f, A1 = 1.f;
#pragma unroll 8
            for (int t = 0; t < SC_LEN; ++t) { const unsigned la = *(const unsigned*)(LOGA + (m0 + t) * LRUW + ch), xi = *(const unsigned*)(XL + (m0 + t) * EVEN_MIX + POOLW + ch);
                const float a0 = __builtin_amdgcn_exp2f(bflo(la)), a1 = __builtin_amdgcn_exp2f(bfhi(la));
                h0 = a0 * h0 + bflo(xi); h1 = a1 * h1 + bfhi(xi); A0 *= a0; A1 *= a1; }
            const size_t ci = ((size_t)b * SC_NCH + chunk) * LRUW + ch;
            *(f32x2*)(CA + ci) = (f32x2){A0, A1}; *(f32x2*)(CH + ci) = (f32x2){h0, h1};
        } else {
            for (int c = 0; c < chunk; ++c) { const size_t ci = ((size_t)b * SC_NCH + c) * LRUW + ch; const f32x2 A = *(const f32x2*)(CA + ci), H = *(const f32x2*)(CH + ci);
                h0 = A[0] * h0 + H[0]; h1 = A[1] * h1 + H[1]; }
#pragma unroll 8
            for (int t = 0; t < SC_LEN; ++t) { const unsigned la = *(const unsigned*)(LOGA + (m0 + t) * LRUW + ch), xi = *(const unsigned*)(XL + (m0 + t) * EVEN_MIX + POOLW + ch), gg = *(const unsigned*)(G + (m0 + t) * LRUW + ch);
                const float a0 = __builtin_amdgcn_exp2f(bflo(la)), a1 = __builtin_amdgcn_exp2f(bfhi(la));
                h0 = a0 * h0 + bflo(xi); h1 = a1 * h1 + bfhi(xi);
                *(unsigned*)(XL + (m0 + t) * EVEN_MIX + POOLW + ch) = cvt_pk_bf16(h0 * bflo(gg), h1 * bfhi(gg)); }
        }
    }
}
__device__ __forceinline__ void rmsrope_phase(const Args& a, int layer, int gw, int NGW, int lane) {
    const int j = layer >> 1;
    const float* DOWN = (const float*)(a.ws + WS_BIG + B_DOWN); bf16_t* CQ = (bf16_t*)(a.ws + WS_BIG + B_CQ); bf16_t* CKV = (bf16_t*)(a.ws + WS_BIG + B_CKV); bf16_t* KPE = (bf16_t*)(a.ws + WS_BIG + B_KPE);
    const float* qg = a.in[I_QNG] + (size_t)j * QL; const float* kg = a.in[I_KVNG] + (size_t)j * KVL;
    const float* COS = (const float*)(a.ws + WS_COS); const float* SIN = (const float*)(a.ws + WS_SIN);
    for (int m = gw; m < M; m += NGW) {
        const float* dr = DOWN + (size_t)m * ODD_IN_PAD;
        f32x2 q[3]; float ss = 0.f;
#pragma unroll
        for (int i = 0; i < 3; ++i) { q[i] = *(const f32x2*)(dr + 128 * i + 2 * lane); ss += q[i][0] * q[i][0] + q[i][1] * q[i][1]; }
        const float rq = 1.0f / sqrtf(wave_sum(ss) * (1.f / QL) + RMS_EPS);
#pragma unroll
        for (int i = 0; i < 3; ++i) { const f32x2 gg = *(const f32x2*)(qg + 128 * i + 2 * lane); *(unsigned*)(CQ + (size_t)m * QL + 128 * i + 2 * lane) = cvt_pk_bf16(q[i][0] * rq * gg[0], q[i][1] * rq * gg[1]); }
        const f32x4 kv = *(const f32x4*)(dr + QL + 4 * lane);
        const float rk = 1.0f / sqrtf(wave_sum((kv[0] * kv[0] + kv[1] * kv[1]) + (kv[2] * kv[2] + kv[3] * kv[3])) * (1.f / KVL) + RMS_EPS);
        const f32x4 gk = *(const f32x4*)(kg + 4 * lane);
        *(u32x2*)(CKV + (size_t)m * KVL + 4 * lane) = pack4(kv * rk * gk);
        const int i = lane & 31; const float x1 = dr[QL + KVL + i], x2 = dr[QL + KVL + 32 + i], c = COS[(size_t)m * 32 + i], s = SIN[(size_t)m * 32 + i];
        const float o = (lane < 32) ? (x1 * c - x2 * s) : (x1 * s + x2 * c);
        const float o_nb = __shfl_xor(o, 1);
        if ((lane & 1) == 0) *(unsigned*)(KPE + (size_t)m * ROPE + lane) = cvt_pk_bf16(o, o_nb);
    }
}
__device__ __forceinline__ void attn_naive_phase(const Args& a, float* lds_f, int gw, int NGW, int lane, int wave) {
    const bf16_t* Q = (const bf16_t*)(a.ws + WS_BIG + B_Q); const bf16_t* KN = (const bf16_t*)(a.ws + WS_BIG + B_KN); const bf16_t* KPE = (const bf16_t*)(a.ws + WS_BIG + B_KPE);
    const bf16_t* V = (const bf16_t*)(a.ws + WS_BIG + B_V); bf16_t* O = (bf16_t*)(a.ws + WS_BIG + B_O);
    float* qs = lds_f + wave * (192 + 2048); float* ps = qs + 192;
    for (int it = gw; it < M * NH; it += NGW) {
        const int h = it & 7, m = it >> 3, b = m / SEQ, t = m % SEQ, nk = 64 * (t / 64 + 1);
        for (int i = lane; i < DQK; i += 64) qs[i] = bf2f(Q[(size_t)m * (NH * DQK) + h * DQK + i]);
        asm volatile("s_waitcnt lgkmcnt(0)" ::: "memory");
        float mx = -3.0e38f;
        for (int kk = lane; kk < nk; kk += 64) { const size_t kr = (size_t)b * SEQ + kk; float s = 0.f;
            for (int d = 0; d < 128; d += 8) { const u32x4 v = *(const u32x4*)(KN + kr * D + h * 128 + d);
                s += qs[d] * bflo(v.x) + qs[d + 1] * bfhi(v.x) + qs[d + 2] * bflo(v.y) + qs[d + 3] * bfhi(v.y) + qs[d + 4] * bflo(v.z) + qs[d + 5] * bfhi(v.z) + qs[d + 6] * bflo(v.w) + qs[d + 7] * bfhi(v.w); }
            for (int d = 0; d < 64; d += 8) { const u32x4 v = *(const u32x4*)(KPE + kr * ROPE + d); const float* qq = qs + 128 + d;
                s += qq[0] * bflo(v.x) + qq[1] * bfhi(v.x) + qq[2] * bflo(v.y) + qq[3] * bfhi(v.y) + qq[4] * bflo(v.z) + qq[5] * bfhi(v.z) + qq[6] * bflo(v.w) + qq[7] * bfhi(v.w); }
            ps[kk] = s; mx = fmaxf(mx, s); }
        mx = wave_max(mx);
        float l = 0.f;
        for (int kk = lane; kk < nk; kk += 64) { const float e = __builtin_amdgcn_exp2f(ps[kk] - mx); ps[kk] = e; l += e; }
        l = wave_sum(l);
        asm volatile("s_waitcnt lgkmcnt(0)" ::: "memory");
        float o0 = 0.f, o1 = 0.f;
        for (int kk = 0; kk < nk; ++kk) { const unsigned v = *(const unsigned*)(V + ((size_t)b * SEQ + kk) * D + h * 128 + 2 * lane); const float p = ps[kk]; o0 += p * bflo(v); o1 += p * bfhi(v); }
        const float il = 1.0f / l;
        *(unsigned*)(O + (size_t)m * D + h * 128 + 2 * lane) = cvt_pk_bf16(o0 * il, o1 * il);
        asm volatile("s_waitcnt lgkmcnt(0)" ::: "memory");
    }
}

template <class Epi>
__device__ __forceinline__ void run_gemm(LAS unsigned char* lds, const Gemm g, const Epi& E) {
#if USE_FAST_GEMM
    pg8::StaticOrder S; S.init(g.M, g.N, (int)gridDim.x, (int)blockIdx.x);
    pg8::gemm_phase<Epi>(lds, g, S, E);
#else
    sgemm_phase<Epi>(g, E);
#endif
}
constexpr int N_PHASES = 39;
__global__ void __launch_bounds__(NWAVES * 64, 2) mega_fwd(Args args) {
    extern __shared__ __attribute__((aligned(16))) unsigned char lds[];
    LAS unsigned char* ldsl = (LAS unsigned char*)lds;
    const int tid = threadIdx.x, lane = tid & 63, wave = __builtin_amdgcn_readfirstlane(tid >> 6);
    const int gw = blockIdx.x * NWAVES + wave, NGW = gridDim.x * NWAVES;
    unsigned char* ws = args.ws;
    volatile LAS unsigned* MISC = (volatile LAS unsigned*)(ldsl + MISC_OFF);
    for (int u = tid; u < (LDS_BYTES - LDSCTL_OFF) / 4; u += NWAVES * 64) ((LAS unsigned*)(ldsl + LDSCTL_OFF))[u] = 0u;
    __syncthreads();
    XcdBarrier bar; bar.bar = (unsigned*)(ws + WS_CTL) + CW_BAR; bar.x = 0; bar.st = nullptr;
#if MK_ONE_LAUNCH
    bar = xcd_barrier_post((unsigned*)(ws + WS_CTL) + CW_BAR, MISC + 8);
#endif
    unsigned char* W = ws + WS_W; unsigned char* BIG = ws + WS_BIG;
    bf16_t* XB = (bf16_t*)(ws + WS_XB);
    float* scr = (float*)lds + wave * 4096;
    for (int ph = args.ph_lo; ph < args.ph_hi; ++ph) {
        if (ph == 0) {
            convert_weights(args, 0, scr, gw, NGW, lane);
            prologue_phase(args, gw, NGW, lane);
        } else {
            const int p = ph - 1; int layer, step;
            if (p < 10) { layer = 0; step = p; } else if (p < 19) { layer = 1; step = p - 10; } else if (p < 29) { layer = 2; step = p - 19; } else { layer = 3; step = p - 29; }
            const bool even = (layer & 1) == 0; const int j = layer >> 1;
            const int nmix = even ? 6 : 5;
            if (step < nmix) {
                const float* xres = (layer == 0) ? args.in[I_X] : (const float*)args.out;
                if (even) {
                    if (step == 0) { Gemm g{XB, (const bf16_t*)(W + W_IN), M, EVEN_IN, D, D, D, 0, 0}; EpiIn E{(bf16_t*)(BIG + B_P1), (bf16_t*)(BIG + B_G)}; run_gemm(ldsl, g, E); }
                    else if (step == 1) convpool_phase(args, layer);
                    else if (step == 2) {
                        { Gemm g{(const bf16_t*)(BIG + B_DU), (const bf16_t*)(W + W_POOL), M, POOLW, 256, EVEN_MIX, 256, 0, 256}; EpiPool E{(bf16_t*)(BIG + B_XL), args.in[I_POOLS] + (size_t)j * POOLW}; run_gemm(ldsl, g, E); }
                        { Gemm g{(const bf16_t*)(BIG + B_DU) + POOLW, (const bf16_t*)(W + W_GATE), M, 2048, 256, EVEN_MIX, 256, 1, 256};
                          EpiGate E{(const bf16_t*)(BIG + B_DU), (bf16_t*)(BIG + B_LOGA), (bf16_t*)(BIG + B_XL), args.in[I_BA] + (size_t)j * LRUW, args.in[I_BX] + (size_t)j * LRUW, (const float*)(ws + WS_SP)}; run_gemm(ldsl, g, E); }
                    }
                    else if (step == 3) scan_phase(args, 1);
                    else if (step == 4) scan_phase(args, 2);
                    else { Gemm g{(const bf16_t*)(BIG + B_XL), (const bf16_t*)(W + W_OUT), M, D, EVEN_MIX, EVEN_MIX, EVEN_MIX, 0, 0}; EpiRes E{xres, args.out}; run_gemm(ldsl, g, E); }
                } else {
                    if (step == 0) { Gemm g{XB, (const bf16_t*)(W + W_DOWN), M, ODD_IN_PAD, D, D, D, 0, 0}; EpiDown E{(float*)(BIG + B_DOWN)}; run_gemm(ldsl, g, E); }
                    else if (step == 1) rmsrope_phase(args, layer, gw, NGW, lane);
                    else if (step == 2) {
                        { Gemm g{(const bf16_t*)(BIG + B_CQ), (const bf16_t*)(W + W_QB), M, NH * DQK, QL, QL, QL, 0, 0}; EpiQ E{(bf16_t*)(BIG + B_Q), (const float*)(ws + WS_COS), (const float*)(ws + WS_SIN)}; run_gemm(ldsl, g, E); }
                        { Gemm g{(const bf16_t*)(BIG + B_CKV), (const bf16_t*)(W + W_KVB), M, 2048, KVL, KVL, KVL, 0, 0}; EpiKV E{(bf16_t*)(BIG + B_KN), (bf16_t*)(BIG + B_V)}; run_gemm(ldsl, g, E); }
                    }
                    else if (step == 3) attn_naive_phase(args, (float*)lds, gw, NGW, lane, wave);
                    else { Gemm g{(const bf16_t*)(BIG + B_O), (const bf16_t*)(W + W_O), M, D, D, D, D, 0, 0}; EpiRes E{xres, args.out}; run_gemm(ldsl, g, E); }
                }
            } else {
                const int s2 = step - nmix;
                if (s2 == 0) ln_phase(args, args.in[I_LNMG] + (size_t)layer * D, args.in[I_LNMB] + (size_t)layer * D, gw, NGW, lane);
                else if (s2 == 1) { Gemm g{XB, (const bf16_t*)(W + W_1), M, FF, D, D, D, 0, 0}; EpiRelu2 E{(bf16_t*)(BIG + B_H)}; run_gemm(ldsl, g, E); }
                else if (s2 == 2) { Gemm g{(const bf16_t*)(BIG + B_H), (const bf16_t*)(W + W_2), M, D, FF, FF, FF, 0, 0}; EpiRes E{(const float*)args.out, args.out}; run_gemm(ldsl, g, E); }
                else { ln_phase(args, args.in[I_LNFG] + (size_t)layer * D, args.in[I_LNFB] + (size_t)layer * D, gw, NGW, lane);
                       if (layer < 3) convert_weights(args, layer + 1, scr, gw, NGW, lane); }
            }
        }
        if (ph + 1 < args.ph_hi) {
#if MK_ONE_LAUNCH
            xcd_barrier(bar);
#endif
        }
    }
}

extern "C" void kernel_launch(void* const* d_in, const int* in_sizes, int n_in, void* d_out, int out_size, void* d_ws, size_t ws_size, hipStream_t stream) {
    static int grid = 0;
    if (grid == 0) {
        if (n_in != 25 || in_sizes[0] != M * D || out_size != M * D || ws_size < WS_END) { fprintf(stderr, "kernel_launch: unexpected shapes: n_in %d in0 %d out %d ws %zu\n", n_in, n_in > 0 ? in_sizes[0] : -1, out_size, ws_size); grid = -1; return; }
        int dev = 0, cus = 0, per_cu = 0;
        if (hipGetDevice(&dev) != hipSuccess || hipDeviceGetAttribute(&cus, hipDeviceAttributeMultiprocessorCount, dev) != hipSuccess) { grid = -1; return; }
        if (hipFuncSetAttribute((const void*)mega_fwd, hipFuncAttributeMaxDynamicSharedMemorySize, LDS_BYTES) != hipSuccess) { fprintf(stderr, "kernel_launch: hipFuncSetAttribute failed\n"); grid = -1; return; }
        if (hipOccupancyMaxActiveBlocksPerMultiprocessor(&per_cu, (const void*)mega_fwd, NWAVES * 64, LDS_BYTES) != hipSuccess || per_cu < 1) { fprintf(stderr, "kernel_launch: occupancy query says %d blocks per CU\n", per_cu); per_cu = 1; }
        (void)hipGetLastError();
        grid = cus;
    }
    if (grid < 0) return;
    (void)hipMemsetAsync((char*)d_ws + WS_CTL, 0, CTL_ZERO_BYTES, stream);
    Args a{};
    for (int i = 0; i < 25; ++i) a.in[i] = (const float*)d_in[i];
    a.out = (float*)d_out; a.ws = (unsigned char*)d_ws;
#if MK_ONE_LAUNCH
    a.ph_lo = 0; a.ph_hi = N_PHASES;
    void* kargs[] = {&a};
    hipError_t e = hipLaunchCooperativeKernel((const void*)mega_fwd, dim3(grid), dim3(NWAVES * 64), kargs, LDS_BYTES, stream);
    if (e != hipSuccess) fprintf(stderr, "kernel_launch: cooperative launch failed: %s (grid %d)\n", hipGetErrorString(e), grid);
#else
    for (int ph = 0; ph < N_PHASES; ++ph) { a.ph_lo = ph; a.ph_hi = ph + 1; hipLaunchKernelGGL(mega_fwd, dim3(grid), dim3(NWAVES * 64), LDS_BYTES, stream, a); }
#endif
}
```

```cpp
#include <hip/hip_runtime.h>
#include <cstdio>
#include <cstdint>
#include <cmath>

#ifndef MK_ONE_LAUNCH
#define MK_ONE_LAUNCH 1
#endif
#ifndef USE_FAST_GEMM
#define USE_FAST_GEMM 1
#endif

#define LAS __attribute__((address_space(3)))
#define GAS __attribute__((address_space(1)))
typedef unsigned short bf16_t;
typedef short bf16x8 __attribute__((ext_vector_type(8)));
typedef float f32x4 __attribute__((ext_vector_type(4)));
typedef float f32x2 __attribute__((ext_vector_type(2)));
typedef float f32x16 __attribute__((ext_vector_type(16)));
typedef unsigned u32x4 __attribute__((ext_vector_type(4)));
typedef unsigned u32x2 __attribute__((ext_vector_type(2)));

constexpr int M = 16384, D = 1024, SEQ = 2048, NBATCH = 8, FF = 4096;
constexpr int POOLW = 512, LRUW = 1024, EVEN_IN = 2560, EVEN_MIX = 1536;
constexpr int QL = 384, KVL = 256, ROPE = 64, ODD_IN = 704, ODD_IN_PAD = 768;
constexpr int NH = 8, DQK = 192, DV = 128;
constexpr float ALPHA = 1.681792830507429f;
constexpr float LN_EPS = 1e-5f, RMS_EPS = 1e-6f;
constexpr float LOG2E = 1.4426950408889634f;
constexpr float QSCALE = 0.07216878364870322f * LOG2E;

constexpr size_t MiB = 1u << 20;
constexpr size_t WS_CTL = 0, CTL_ZERO_BYTES = 1 * MiB;
constexpr size_t WS_COS = 1 * MiB, WS_SIN = 3 * MiB;
constexpr size_t WS_CARRY = 5 * MiB;
constexpr size_t WS_SP = 7 * MiB;
constexpr size_t WS_W = 8 * MiB;
constexpr size_t WS_XB = 36 * MiB;
constexpr size_t WS_BIG = 68 * MiB;
constexpr size_t W_IN = 0, W_POOL = 5 * MiB, W_GATE = 5 * MiB + 256 * 1024, W_OUT = 6 * MiB + 256 * 1024;
constexpr size_t W_DOWN = 0, W_QB = 1 * MiB + 512 * 1024, W_KVB = 3 * MiB, W_O = 4 * MiB;
constexpr size_t W_1 = 10 * MiB, W_2 = 18 * MiB;
constexpr size_t B_P1 = 0, B_LOGA = 0, B_G = 48 * MiB, B_DU = 80 * MiB, B_XL = 128 * MiB;
constexpr size_t B_DOWN = 0, B_Q = 0, B_CQ = 48 * MiB, B_CKV = 60 * MiB, B_KPE = 68 * MiB, B_KN = 72 * MiB, B_V = 104 * MiB, B_O = 136 * MiB;
constexpr size_t B_H = 0;
constexpr size_t WS_END = 256 * MiB;
static_assert(WS_BIG + B_XL + (size_t)M * EVEN_MIX * 2 <= WS_END && WS_BIG + B_O + (size_t)M * D * 2 <= WS_END && WS_BIG + (size_t)M * FF * 2 <= WS_END, "ws map");

constexpr int CW_BAR = 4096;

constexpr int RING_BYTES = 131072;
constexpr int LDSCTL_OFF = RING_BYTES, MISC_OFF = LDSCTL_OFF + 320;
constexpr int LDS_BYTES = 147456;
constexpr int NWAVES = 8;

typedef __bf16 bf16x2_t __attribute__((ext_vector_type(2)));
__device__ __forceinline__ unsigned cvt_pk_bf16(float lo, float hi) { const f32x2 v = {lo, hi}; const bf16x2_t b = __builtin_convertvector(v, bf16x2_t); return __builtin_bit_cast(unsigned, b); }
__device__ __forceinline__ float bf2f(unsigned short u) { return __uint_as_float((unsigned)u << 16); }
__device__ __forceinline__ float bflo(unsigned u) { return __uint_as_float(u << 16); }
__device__ __forceinline__ float bfhi(unsigned u) { return __uint_as_float(u & 0xffff0000u); }
__device__ __forceinline__ u32x2 pack4(f32x4 v) { u32x2 w; w.x = cvt_pk_bf16(v[0], v[1]); w.y = cvt_pk_bf16(v[2], v[3]); return w; }
__device__ __forceinline__ float wave_sum(float v) {
#pragma unroll
    for (int o = 1; o < 64; o <<= 1) v += __shfl_xor(v, o);
    return v;
}
__device__ __forceinline__ float wave_max(float v) {
#pragma unroll
    for (int o = 1; o < 64; o <<= 1) v = fmaxf(v, __shfl_xor(v, o));
    return v;
}
__device__ __forceinline__ float sigmoidf_(float x) { return __builtin_amdgcn_rcpf(1.0f + __builtin_amdgcn_exp2f(-x * LOG2E)); }
__device__ __forceinline__ float gelu_tanh(float x) {
    const float u = 0.7978845608028654f * (x + 0.044715f * x * x * x);
    const float t = __builtin_amdgcn_exp2f(2.0f * LOG2E * u);
    const float th = 1.0f - 2.0f * __builtin_amdgcn_rcpf(t + 1.0f);
    return 0.5f * x * (1.0f + th);
}

struct Unit { int pm, pn; };
struct Gemm { const bf16_t* A; const bf16_t* Bt; int M, N, K, lda, ldb, ashift, amul; };

template <class Epi>
__device__ __forceinline__ void sgemm_phase(const Gemm g, const Epi& E) {
    const int tid = threadIdx.x, lane = tid & 63, wave = tid >> 6, r = lane & 31, hi = lane >> 5;
    const int nM = g.M / 256, nN = g.N / 256, nU = nM * nN;
    for (int u = blockIdx.x; u < nU; u += gridDim.x) {
        const int pm = u / nN, pn = u % nN;
        const bf16_t* A = g.A + (size_t)(pm * 256 + wave * 32 + r) * g.lda + (size_t)((pn >> g.ashift) * g.amul) + 8 * hi;
        const bf16_t* B = g.Bt + (size_t)(pn * 256 + r) * g.ldb + 8 * hi;
        for (int cb = 0; cb < 4; ++cb) {
            f32x16 acc0 = {}, acc1 = {};
            const bf16_t* B0 = B + (size_t)(cb * 32) * g.ldb;
            const bf16_t* B1 = B0 + (size_t)128 * g.ldb;
            for (int k0 = 0; k0 < g.K; k0 += 16) {
                const bf16x8 a = *(const bf16x8*)(A + k0);
                const bf16x8 b0 = *(const bf16x8*)(B0 + k0);
                const bf16x8 b1 = *(const bf16x8*)(B1 + k0);
                acc0 = __builtin_amdgcn_mfma_f32_32x32x16_bf16(b0, a, acc0, 0, 0, 0);
                acc1 = __builtin_amdgcn_mfma_f32_32x32x16_bf16(b1, a, acc1, 0, 0, 0);
            }
            const int row = pm * 256 + wave * 32 + r;
#pragma unroll
            for (int q = 0; q < 4; ++q) {
                const f32x4 v0 = {acc0[4 * q], acc0[4 * q + 1], acc0[4 * q + 2], acc0[4 * q + 3]};
                const f32x4 v1 = {acc1[4 * q], acc1[4 * q + 1], acc1[4 * q + 2], acc1[4 * q + 3]};
                E(row, pn, cb * 32 + 8 * q + 4 * hi, v0, v1);
            }
        }
    }
}

struct EpiIn {
    bf16_t* P1; bf16_t* G;
    __device__ __forceinline__ void operator()(int row, int pn, int cc, f32x4 v0, f32x4 v1) const {
        if (pn < 6) { bf16_t* p = P1 + (size_t)row * EVEN_MIX + pn * 256 + cc; *(u32x2*)p = pack4(v0); *(u32x2*)(p + 128) = pack4(v1); }
        else { bf16_t* p = G + (size_t)row * LRUW + (pn - 6) * 256 + cc;
#pragma unroll
            for (int e = 0; e < 4; ++e) { v0[e] = gelu_tanh(v0[e]); v1[e] = gelu_tanh(v1[e]); }
            *(u32x2*)p = pack4(v0); *(u32x2*)(p + 128) = pack4(v1); }
    }
};
struct EpiPool {
    bf16_t* XL; const float* scale;
    __device__ __forceinline__ void operator()(int row, int pn, int cc, f32x4 v0, f32x4 v1) const {
        const int c = pn * 256 + cc; const f32x4 s0 = *(const f32x4*)(scale + c), s1 = *(const f32x4*)(scale + c + 128);
        bf16_t* p = XL + (size_t)row * EVEN_MIX + c; *(u32x2*)p = pack4(v0 * s0); *(u32x2*)(p + 128) = pack4(v1 * s1);
    }
};
struct EpiGate {
    const bf16_t* DU; bf16_t* LOGA; bf16_t* XL; const float* b_a; const float* b_x; const float* sp8;
    __device__ __forceinline__ void operator()(int row, int pn, int cc, f32x4 v0, f32x4 v1) const {
        const int ch = pn * 128 + cc;
        const f32x4 ba = *(const f32x4*)(b_a + ch), bx = *(const f32x4*)(b_x + ch), sp = *(const f32x4*)(sp8 + ch);
        const u32x2 uu = *(const u32x2*)(DU + (size_t)row * EVEN_MIX + POOLW + ch);
        const float uf[4] = {bflo(uu.x), bfhi(uu.x), bflo(uu.y), bfhi(uu.y)};
        f32x4 la, xi;
#pragma unroll
        for (int e = 0; e < 4; ++e) {
            const float rg = sigmoidf_(v0[e] + ba[e]), ig = sigmoidf_(v1[e] + bx[e]);
            const float log_a = rg * sp[e];
            const float mult = sqrtf(fmaxf(-expm1f(2.0f * log_a), 0.0f));
            la[e] = log_a * LOG2E; xi[e] = mult * (ig * uf[e]);
        }
        *(u32x2*)(LOGA + (size_t)row * LRUW + ch) = pack4(la);
        *(u32x2*)(XL + (size_t)row * EVEN_MIX + POOLW + ch) = pack4(xi);
    }
};
struct EpiRes {
    const float* res; float* out;
    __device__ __forceinline__ void operator()(int row, int pn, int cc, f32x4 v0, f32x4 v1) const {
        const size_t o = (size_t)row * D + pn * 256 + cc;
        const f32x4 r0 = *(const f32x4*)(res + o), r1 = *(const f32x4*)(res + o + 128);
        *(f32x4*)(out + o) = r0 * ALPHA + v0; *(f32x4*)(out + o + 128) = r1 * ALPHA + v1;
    }
};
struct EpiRelu2 {
    bf16_t* H;
    __device__ __forceinline__ void operator()(int row, int pn, int cc, f32x4 v0, f32x4 v1) const {
#pragma unroll
        for (int e = 0; e < 4; ++e) { const float a = fmaxf(v0[e], 0.f), b = fmaxf(v1[e], 0.f); v0[e] = a * a; v1[e] = b * b; }
        bf16_t* p = H + (size_t)row * FF + pn * 256 + cc; *(u32x2*)p = pack4(v0); *(u32x2*)(p + 128) = pack4(v1);
    }
};
struct EpiDown {
    float* DOWN;
    __device__ __forceinline__ void operator()(int row, int pn, int cc, f32x4 v0, f32x4 v1) const {
        float* p = DOWN + (size_t)row * ODD_IN_PAD + pn * 256 + cc; *(f32x4*)p = v0; *(f32x4*)(p + 128) = v1;
    }
};
struct EpiQ {
    bf16_t* Q; const float* COS; const float* SIN;
    __device__ __forceinline__ void operator()(int row, int pn, int cc, f32x4 v0, f32x4 v1) const {
        bf16_t* qr = Q + (size_t)row * (NH * DQK);
        if (pn < 4) { *(u32x2*)(qr + (2 * pn) * DQK + cc) = pack4(v0 * QSCALE); *(u32x2*)(qr + (2 * pn + 1) * DQK + cc) = pack4(v1 * QSCALE); }
        else { const int h = 4 * (pn - 4) + (cc >> 5), i = cc & 31;
            const f32x4 c = *(const f32x4*)(COS + (size_t)row * 32 + i), s = *(const f32x4*)(SIN + (size_t)row * 32 + i);
            const f32x4 o1 = (v0 * c - v1 * s) * QSCALE, o2 = (v0 * s + v1 * c) * QSCALE;
            *(u32x2*)(qr + h * DQK + 128 + i) = pack4(o1); *(u32x2*)(qr + h * DQK + 160 + i) = pack4(o2); }
    }
};
struct EpiKV {
    bf16_t* KN; bf16_t* V;
    __device__ __forceinline__ void operator()(int row, int pn, int cc, f32x4 v0, f32x4 v1) const {
        bf16_t* p = (pn < 4 ? KN : V) + (size_t)row * D + (pn & 3) * 256 + cc; *(u32x2*)p = pack4(v0); *(u32x2*)(p + 128) = pack4(v1);
    }
};

namespace pg8 {
constexpr int BM = 256, BK = 64, HALF = 128, HTB = HALF * BK * 2, STAGE_BYTES = 8 * HTB, NXCD = 8, WGM = 8;
__host__ __device__ __forceinline__ int lds_byte(int r, int c) { const int st = (r >> 4) * 2 + (c >> 5), rr = r & 15, cc = c & 31, ob = rr * 64 + cc * 2; return st * 1024 + (ob ^ (((ob >> 9) & 1) << 5)); }
__host__ __device__ __forceinline__ void stage_rc(int b, int& R, int& C) { const int st = b / 1024, sb = b % 1024, swz = sb ^ (((sb >> 9) & 1) << 5); R = (st >> 1) * 16 + swz / 64; C = (st & 1) * 32 + (swz % 64) / 2; }
struct StaticOrder {
    int nM, nN, nwg, G, c;
    __device__ void init(int M_, int N_, int G_, int c_) { nM = M_ / BM; nN = N_ / BM; nwg = nM * nN; G = G_; c = c_; }
    __device__ bool next(int i, Unit& u) const {
        const long L = (long)i * G + c; if (L >= nwg) return false;
        int wgid = (int)L; { const int q = nwg / NXCD, r = nwg % NXCD, xcd = wgid % NXCD, off = wgid / NXCD; wgid = (xcd < r ? xcd * (q + 1) : r * (q + 1) + (xcd - r) * q) + off; }
        const int nig = WGM * nN, gid = wgid / nig, fm = gid * WGM, gsz = (nM - fm) < WGM ? (nM - fm) : WGM;
        u.pm = fm + ((wgid % nig) % gsz); u.pn = (wgid % nig) / gsz; return true;
    }
};
template <class Epi>
__device__ __forceinline__ void gemm_phase(LAS unsigned char* lds, const Gemm g, const StaticOrder& S, const Epi& E) {
    int tid_ = threadIdx.x; asm volatile("" : "+v"(tid_));
    const int tid = tid_, wid = __builtin_amdgcn_readfirstlane(tid >> 6), lane = tid & 63, wr = wid >> 2, wc = wid & 3, fr = lane & 15, fq = lane >> 4;
    const int K = g.K, nt = K / BK;
    unsigned voffA[2], voffB[2];
#pragma unroll
    for (int i = 0; i < 2; ++i) { int R, C; stage_rc(tid * 16 + i * 8192, R, C); voffA[i] = (unsigned)(R * g.lda + C) * 2u; voffB[i] = (unsigned)(R * g.ldb + C) * 2u; }
    const size_t kstep = (size_t)(BK * 2);
    const size_t hstepA = (size_t)HALF * g.lda * 2, hstepB = (size_t)HALF * g.ldb * 2;
    const size_t tstepA = 2 * hstepA, tstepB = 2 * hstepB;
    const unsigned ldsw = (unsigned)wid * 1024u;
    const int aoff = lds_byte(wr * 64 + fr, fq * 8), boff = lds_byte(wc * 32 + fr, fq * 8);
#define PG8_SA(b, h) (((b) * 2 + (h)) * HTB)
#define PG8_SB(b, h) ((4 + (b) * 2 + (h)) * HTB)
#define PG8_STAGE(bufoff, gbase, voff) do { _Pragma("unroll") for (int _i = 0; _i < 2; ++_i) \
        __builtin_amdgcn_global_load_lds((const unsigned*)((const char*)(gbase) + (voff)[_i]), (LAS unsigned*)(lds + (bufoff) + ldsw + _i * 8192), 16, 0, 0); } while (0)
#define PG8_LDA(dst, b, h) do { _Pragma("unroll") for (int m = 0; m < 4; ++m) _Pragma("unroll") for (int k = 0; k < 2; ++k) dst[m][k] = *(const LAS bf16x8*)(lds + PG8_SA(b, h) + aoff + m * 2048 + k * 1024); } while (0)
#define PG8_LDB(dst, b, h) do { _Pragma("unroll") for (int n = 0; n < 2; ++n) _Pragma("unroll") for (int k = 0; k < 2; ++k) dst[n][k] = *(const LAS bf16x8*)(lds + PG8_SB(b, h) + boff + n * 2048 + k * 1024); } while (0)
#define PG8_MMA(ai, bj, At, Bt) do { __builtin_amdgcn_s_setprio(1); _Pragma("unroll") for (int m = 0; m < 4; ++m) _Pragma("unroll") for (int n = 0; n < 2; ++n) _Pragma("unroll") for (int k = 0; k < 2; ++k) \
        acc[ai][bj][m][n] = __builtin_amdgcn_mfma_f32_16x16x32_bf16(Bt[n][k], At[m][k], acc[ai][bj][m][n], 0, 0, 0); __builtin_amdgcn_s_setprio(0); } while (0)
#define PG8_WAIT_V(n) asm volatile("s_waitcnt vmcnt(" #n ")" ::: "memory")
#define PG8_WAIT_L(n) asm volatile("s_waitcnt lgkmcnt(" #n ")" ::: "memory")
#define PG8_BAR __builtin_amdgcn_s_barrier()
#define PG8_SCHED __builtin_amdgcn_sched_barrier(0)
#define PG8_APTR(u) ((const char*)g.A + (size_t)(u).pm * tstepA + (size_t)(((u).pn >> g.ashift) * g.amul) * 2)
#define PG8_BPTR(u) ((const char*)g.Bt + (size_t)(u).pn * tstepB)
    Unit cur, nxt; int ui = 0;
    if (!S.next(0, cur)) return;
    f32x4 acc[2][2][4][2];
#pragma unroll
    for (int a = 0; a < 2; ++a)
#pragma unroll
        for (int b = 0; b < 2; ++b)
#pragma unroll
            for (int m = 0; m < 4; ++m)
#pragma unroll
                for (int n = 0; n < 2; ++n) acc[a][b][m][n] = (f32x4){0.f, 0.f, 0.f, 0.f};
    bf16x8 At[4][2], B0[2][2], B1[2][2];
    const char* cA = PG8_APTR(cur); const char* cB = PG8_BPTR(cur);
    PG8_STAGE(PG8_SB(0, 0), cB, voffB); PG8_STAGE(PG8_SB(0, 1), cB + hstepB, voffB); PG8_STAGE(PG8_SA(0, 0), cA, voffA); PG8_STAGE(PG8_SA(0, 1), cA + hstepA, voffA);
    if (wr == 1) PG8_BAR;
    PG8_WAIT_V(2); PG8_BAR;
    PG8_STAGE(PG8_SB(1, 0), cB + kstep, voffB); PG8_STAGE(PG8_SA(1, 0), cA + kstep, voffA); PG8_STAGE(PG8_SB(1, 1), cB + hstepB + kstep, voffB);
    PG8_WAIT_V(6); PG8_BAR;
    for (;;) {
        const bool has_next = S.next(ui + 1, nxt);
        const char* nA = has_next ? PG8_APTR(nxt) : cA; const char* nB = has_next ? PG8_BPTR(nxt) : cB;
#pragma unroll 1
        for (int t = 0; t < nt; t += 2) {
            const bool last = (t == nt - 2);
            const char* a1 = cA + (size_t)(t + 1) * kstep;
            const char* a2 = last ? nA : cA + (size_t)(t + 2) * kstep; const char* b2 = last ? nB : cB + (size_t)(t + 2) * kstep;
            const char* a3 = a2 + kstep; const char* b3 = b2 + kstep;
            PG8_LDB(B0, 0, 0); PG8_LDB(B1, 0, 1); PG8_SCHED; PG8_LDA(At, 0, 0); PG8_STAGE(PG8_SA(1, 1), a1 + hstepA, voffA);
            PG8_WAIT_V(8); PG8_WAIT_L(0); PG8_BAR; PG8_MMA(0, 0, At, B0); PG8_MMA(0, 1, At, B1); PG8_BAR; PG8_SCHED;
            PG8_LDA(At, 0, 1); PG8_STAGE(PG8_SB(0, 0), b2, voffB); PG8_STAGE(PG8_SB(0, 1), b2 + hstepB, voffB); PG8_STAGE(PG8_SA(0, 0), a2, voffA);
            PG8_WAIT_V(8); PG8_WAIT_L(0); PG8_BAR; PG8_MMA(1, 0, At, B0); PG8_MMA(1, 1, At, B1); PG8_BAR; PG8_SCHED;
            PG8_LDB(B0, 1, 0); PG8_LDB(B1, 1, 1); PG8_SCHED; PG8_LDA(At, 1, 0); PG8_STAGE(PG8_SA(0, 1), a2 + hstepA, voffA);
            PG8_WAIT_V(8); PG8_WAIT_L(0); PG8_BAR; PG8_MMA(0, 0, At, B0); PG8_MMA(0, 1, At, B1); PG8_BAR; PG8_SCHED;
            PG8_LDA(At, 1, 1); PG8_STAGE(PG8_SB(1, 0), b3, voffB); PG8_STAGE(PG8_SB(1, 1), b3 + hstepB, voffB); PG8_STAGE(PG8_SA(1, 0), a3, voffA);
            PG8_WAIT_V(8); PG8_WAIT_L(0); PG8_BAR; PG8_MMA(1, 0, At, B0); PG8_MMA(1, 1, At, B1); PG8_BAR; PG8_SCHED;
        }
        if (wr == 0) PG8_BAR;
        {
#pragma unroll
            for (int ai = 0; ai < 2; ++ai)
#pragma unroll
                for (int m = 0; m < 4; ++m) { const int row = cur.pm * BM + ai * HALF + wr * 64 + m * 16 + fr;
#pragma unroll
                    for (int n = 0; n < 2; ++n) E(row, cur.pn, wc * 32 + n * 16 + 4 * fq, acc[ai][0][m][n], acc[ai][1][m][n]);
                    asm volatile("" ::: "memory"); }
        }
        if (!has_next) break;
#pragma unroll
        for (int a = 0; a < 2; ++a)
#pragma unroll
            for (int b = 0; b < 2; ++b)
#pragma unroll
                for (int m = 0; m < 4; ++m)
#pragma unroll
                    for (int n = 0; n < 2; ++n) acc[a][b][m][n] = (f32x4){0.f, 0.f, 0.f, 0.f};
        cur = nxt; cA = nA; cB = nB; ++ui;
        if (wr == 1) PG8_BAR;
    }
    PG8_WAIT_V(0);
    PG8_BAR;
#undef PG8_SA
#undef PG8_SB
#undef PG8_STAGE
#undef PG8_LDA
#undef PG8_LDB
#undef PG8_MMA
#undef PG8_WAIT_V
#undef PG8_WAIT_L
#undef PG8_BAR
#undef PG8_SCHED
#undef PG8_APTR
#undef PG8_BPTR
}
}

#define XB_TMO      128
#define XB_XCNT(j)  (256  + 64 * (j))
#define XB_XSUB(j)  (1280 + 64 * (j))
#define XB_XGEN(j)  (2304 + 64 * (j))
#define XB_TOP      3328
#define XB_TOPGEN   3392
#define XCD_BAR_WORDS 3456
#define XB_SPIN_CAP (1u << 18)
__device__ __forceinline__ unsigned xb_ld(unsigned* p)              { return __hip_atomic_load(p, __ATOMIC_RELAXED, __HIP_MEMORY_SCOPE_AGENT); }
__device__ __forceinline__ unsigned xb_add(unsigned* p, unsigned v) { return __hip_atomic_fetch_add(p, v, __ATOMIC_RELAXED, __HIP_MEMORY_SCOPE_AGENT); }
__device__ __forceinline__ unsigned xb_xcc_id() { return (unsigned)__builtin_amdgcn_s_getreg((3 << 11) | 20) & 0xFu; }
#define XB_SPIN(cond, bar) do { unsigned _sp = 0; while (cond) { __builtin_amdgcn_s_sleep(1); \
    if ((++_sp & 255u) == 0u) { if (xb_ld(&(bar)[XB_TMO])) break; if (_sp > XB_SPIN_CAP) { atomicAdd(&(bar)[XB_TMO], 1u); break; } } } } while (0)
struct XcdBarrier { unsigned* bar; unsigned x; volatile LAS unsigned* st; };
__device__ __forceinline__ XcdBarrier xcd_barrier_post(unsigned* bar, volatile LAS unsigned* st) {
    XcdBarrier b; b.bar = bar; b.x = xb_xcc_id(); b.st = st;
    if (threadIdx.x == 0) (void)xb_add(&bar[XB_XCNT(b.x)], 1u);
    return b;
}
__device__ __forceinline__ void xcd_barrier_complete(unsigned* bar, unsigned x, unsigned& nloc, unsigned& nx) {
    const unsigned G = gridDim.x * gridDim.y * gridDim.z;
    unsigned sum, cnt, mine, sp = 0u;
    for (;;) {
        sum = 0u; cnt = 0u; mine = 0u;
#pragma unroll
        for (unsigned j = 0; j < 16; ++j) { const unsigned c = xb_ld(&bar[XB_XCNT(j)]); sum += c; cnt += (c > 0u) ? 1u : 0u; mine = (j == x) ? c : mine; }
        if (sum == G) break;
        __builtin_amdgcn_s_sleep(1);
        if ((++sp & 255u) == 0u) { if (xb_ld(&bar[XB_TMO])) break; if (sp > XB_SPIN_CAP) { atomicAdd(&bar[XB_TMO], 1u); break; } }
    }
    nloc = mine > 0u ? mine : 1u; nx = cnt > 0u ? cnt : 1u;
}
__device__ __forceinline__ void xcd_barrier(const XcdBarrier& b) {
    asm volatile("s_waitcnt vmcnt(0)" ::: "memory");
    __syncthreads();
    if (threadIdx.x == 0) {
        unsigned* bar = b.bar;
        __builtin_amdgcn_s_waitcnt(0);
        unsigned nloc = b.st[0], nx = b.st[1];
        if (nloc == 0u) { xcd_barrier_complete(bar, b.x, nloc, nx); b.st[0] = nloc; b.st[1] = nx; }
        const unsigned old = xb_add(&bar[XB_XSUB(b.x)], 1u);
        const unsigned gen = old / nloc;
        if (old + 1u == (gen + 1u) * nloc) {
            __builtin_amdgcn_fence(__ATOMIC_RELEASE, "agent");
            asm volatile("s_waitcnt vmcnt(0)" ::: "memory");
            const unsigned og = xb_add(&bar[XB_TOP], 1u);
            const unsigned tg = og / nx;
            if (og + 1u == (tg + 1u) * nx) xb_add(&bar[XB_TOPGEN], 1u);
            else XB_SPIN(xb_ld(&bar[XB_TOPGEN]) == tg, bar);
            __builtin_amdgcn_fence(__ATOMIC_ACQUIRE, "agent");
            xb_add(&bar[XB_XGEN(b.x)], 1u);
            asm volatile("s_waitcnt vmcnt(0)" ::: "memory");
        } else {
            XB_SPIN(xb_ld(&bar[XB_XGEN(b.x)]) == gen, bar);
            __builtin_amdgcn_fence(__ATOMIC_ACQUIRE, "agent");
            asm volatile("s_waitcnt vmcnt(0)" ::: "memory");
        }
    }
    __syncthreads();
}

struct Args {
    const float* in[25];
    float* out; unsigned char* ws;
    int ph_lo, ph_hi;
};
enum { I_X = 0, I_POS, I_LNMG, I_LNMB, I_LNFG, I_LNFB, I_EWIN, I_POOLW, I_POOLS, I_CONVW, I_CONVB, I_WA, I_BA, I_WX, I_BX, I_LAM, I_EWOUT,
       I_WDOWN, I_QNG, I_KVNG, I_WQB, I_WKVB, I_WO, I_W1, I_W2 };

__device__ __forceinline__ void transpose_item(const float* src, int ld_src, int src_row0, int src_col0, bf16_t* dst, int ld_dst, int dst_row0, int dst_col0, bool zero, float* scr, int lane) {
    if (!zero) {
#pragma unroll 8
        for (int i = 0; i < 32; ++i) { const int kk = 2 * i + (lane >> 5); scr[kk * 33 + (lane & 31)] = src[(size_t)(src_row0 + kk) * ld_src + src_col0 + (lane & 31)]; }
    }
    asm volatile("s_waitcnt lgkmcnt(0)" ::: "memory");
    const int c = lane & 7;
#pragma unroll
    for (int j = 0; j < 4; ++j) { const int n = (lane >> 3) + 8 * j; const float* s = scr + (8 * c) * 33 + n;
        u32x4 o = {0u, 0u, 0u, 0u};
        if (!zero) { o.x = cvt_pk_bf16(s[0 * 33], s[1 * 33]); o.y = cvt_pk_bf16(s[2 * 33], s[3 * 33]); o.z = cvt_pk_bf16(s[4 * 33], s[5 * 33]); o.w = cvt_pk_bf16(s[6 * 33], s[7 * 33]); }
        *(u32x4*)(dst + (size_t)(dst_row0 + n) * ld_dst + dst_col0 + 8 * c) = o; }
    asm volatile("s_waitcnt lgkmcnt(0)" ::: "memory");
}
__device__ __forceinline__ void conv_plain(const float* src, int K, int N, int Npad, bf16_t* dst, float* scr, int gw, int NGW, int lane) {
    const int nblk = Npad / 32, items = (K / 64) * nblk;
    for (int it = gw; it < items; it += NGW) { const int kb = it / nblk, nb = it % nblk;
        transpose_item(src, N, 64 * kb, 32 * nb, dst, K, 32 * nb, 64 * kb, 32 * nb >= N, scr, lane); }
}
__device__ __forceinline__ void convert_weights(const Args& a, int layer, float* scr, int gw, int NGW, int lane) {
    unsigned char* W = a.ws + WS_W; const int j = layer >> 1;
    if ((layer & 1) == 0) {
        conv_plain(a.in[I_EWIN] + (size_t)j * D * EVEN_IN, D, EVEN_IN, EVEN_IN, (bf16_t*)(W + W_IN), scr, gw, NGW, lane);
        conv_plain(a.in[I_EWOUT] + (size_t)j * EVEN_MIX * D, EVEN_MIX, D, D, (bf16_t*)(W + W_OUT), scr, gw, NGW, lane);
        {
            const float* pw = a.in[I_POOLW] + (size_t)j * 4 * 128 * 128; bf16_t* dst = (bf16_t*)(W + W_POOL);
            for (int it = gw; it < 16 * 4; it += NGW) { const int nb = it >> 2, kb = it & 3, g = nb >> 2; const bool nz = (kb >> 1) == (g & 1);
                transpose_item(pw + (size_t)g * 128 * 128, 128, 64 * (kb & 1), 32 * (nb & 3), dst, 256, 32 * nb, 64 * kb, !nz, scr, lane); }
        }
        {
            const float* wa = a.in[I_WA] + (size_t)j * 8 * 128 * 128; const float* wx = a.in[I_WX] + (size_t)j * 8 * 128 * 128; bf16_t* dst = (bf16_t*)(W + W_GATE);
            for (int it = gw; it < 64 * 4; it += NGW) { const int nb = it >> 2, kb = it & 3, h = nb >> 3, half = (nb >> 2) & 1; const bool nz = (kb >> 1) == (h & 1);
                transpose_item((half ? wx : wa) + (size_t)h * 128 * 128, 128, 64 * (kb & 1), 32 * (nb & 3), dst, 256, 32 * nb, 64 * kb, !nz, scr, lane); }
        }
        {
            float* sp = (float*)(a.ws + WS_SP); const float* lam = a.in[I_LAM] + (size_t)j * LRUW;
            for (int i = gw * 64 + lane; i < LRUW; i += NGW * 64) { const float l = lam[i]; sp[i] = -8.0f * (l > 15.f ? expf(-l) : log1pf(expf(-l))); }
        }
    } else {
        conv_plain(a.in[I_WDOWN] + (size_t)j * D * ODD_IN, D, ODD_IN, ODD_IN_PAD, (bf16_t*)(W + W_DOWN), scr, gw, NGW, lane);
        conv_plain(a.in[I_WO] + (size_t)j * D * D, D, D, D, (bf16_t*)(W + W_O), scr, gw, NGW, lane);
        {
            const float* wq = a.in[I_WQB] + (size_t)j * QL * (NH * DQK); bf16_t* dst = (bf16_t*)(W + W_QB);
            for (int it = gw; it < 6 * 48; it += NGW) { const int kb = it / 48, nb = it % 48, n0 = 32 * nb; int sc;
                if (n0 < 1024) sc = (n0 >> 7) * DQK + (n0 & 127);
                else { const int m = n0 - 1024, p = m >> 8, half = (m >> 7) & 1, hl = (m >> 5) & 3; sc = (4 * p + hl) * DQK + 128 + half * 32; }
                transpose_item(wq, NH * DQK, 64 * kb, sc, dst, QL, n0, 64 * kb, false, scr, lane); }
        }
        {
            const float* wkv = a.in[I_WKVB] + (size_t)j * KVL * (NH * 256); bf16_t* dst = (bf16_t*)(W + W_KVB);
            for (int it = gw; it < 4 * 64; it += NGW) { const int kb = it / 64, nb = it % 64, n0 = 32 * nb; const int m = n0 & 1023;
                const int sc = (m >> 7) * 256 + (n0 >= 1024 ? 128 : 0) + (m & 127);
                transpose_item(wkv, NH * 256, 64 * kb, sc, dst, KVL, n0, 64 * kb, false, scr, lane); }
        }
    }
    conv_plain(a.in[I_W1] + (size_t)layer * D * FF, D, FF, FF, (bf16_t*)(W + W_1), scr, gw, NGW, lane);
    conv_plain(a.in[I_W2] + (size_t)layer * FF * D, FF, D, D, (bf16_t*)(W + W_2), scr, gw, NGW, lane);
}

__device__ __forceinline__ void ln_row(float* xrow, bf16_t* brow, const float* g, const float* b, int lane) {
    f32x4 v[4]; float s = 0.f;
#pragma unroll
    for (int j = 0; j < 4; ++j) { v[j] = *(const f32x4*)(xrow + 4 * lane + 256 * j); s += (v[j][0] + v[j][1]) + (v[j][2] + v[j][3]); }
    const float mean = wave_sum(s) * (1.f / D); float s2 = 0.f;
#pragma unroll
    for (int j = 0; j < 4; ++j) { v[j] = v[j] - mean; s2 += (v[j][0] * v[j][0] + v[j][1] * v[j][1]) + (v[j][2] * v[j][2] + v[j][3] * v[j][3]); }
    const float rstd = 1.0f / sqrtf(wave_sum(s2) * (1.f / D) + LN_EPS);
#pragma unroll
    for (int j = 0; j < 4; ++j) { const f32x4 gg = *(const f32x4*)(g + 4 * lane + 256 * j), bb = *(const f32x4*)(b + 4 * lane + 256 * j);
        const f32x4 o = v[j] * rstd * gg + bb; *(f32x4*)(xrow + 4 * lane + 256 * j) = o; *(u32x2*)(brow + 4 * lane + 256 * j) = pack4(o); }
}
__device__ __forceinline__ void ln_phase(const Args& a, const float* g, const float* b, int gw, int NGW, int lane) {
    bf16_t* XB = (bf16_t*)(a.ws + WS_XB);
    for (int m = gw; m < M; m += NGW) ln_row(a.out + (size_t)m * D, XB + (size_t)m * D, g, b, lane);
}
__device__ __forceinline__ void prologue_phase(const Args& a, int gw, int NGW, int lane) {
    bf16_t* XB = (bf16_t*)(a.ws + WS_XB); const float* x = a.in[I_X];
    for (int m = gw; m < M; m += NGW) {
#pragma unroll
        for (int j = 0; j < 4; ++j) { const f32x4 v = *(const f32x4*)(x + (size_t)m * D + 4 * lane + 256 * j); *(u32x2*)(XB + (size_t)m * D + 4 * lane + 256 * j) = pack4(v); }
    }
    float* COS = (float*)(a.ws + WS_COS); float* SIN = (float*)(a.ws + WS_SIN); const int* pos = (const int*)a.in[I_POS];
    for (int i = gw * 64 + lane; i < M * 32; i += NGW * 64) { const int m = i >> 5, f = i & 31;
        const float inv = powf(10000.0f, -(float)(2 * f) / 64.0f); const float ang = (float)pos[m] * inv;
        COS[i] = cosf(ang); SIN[i] = sinf(ang); }
}
__device__ __forceinline__ void convpool_phase(const Args& a, int layer) {
    const int j = layer >> 1;
    const bf16_t* P1 = (const bf16_t*)(a.ws + WS_BIG + B_P1); bf16_t* DU = (bf16_t*)(a.ws + WS_BIG + B_DU);
    const float* cw = a.in[I_CONVW] + (size_t)j * 4 * LRUW; const float* cb = a.in[I_CONVB] + (size_t)j * LRUW;
    const int nitems = M * 192;
    for (int it = blockIdx.x * 512 + threadIdx.x; it < nitems; it += gridDim.x * 512) {
        const int m = it / 192, c8 = it % 192, t = m & (SEQ - 1);
        float o[8];
        if (c8 < 64) {
            const int c = 8 * c8, w = 2 << (c8 >> 4), n = (t + 1 < w) ? (t + 1) : w;
            float s[8], cur[8];
#pragma unroll
            for (int e = 0; e < 8; ++e) s[e] = 0.f;
            for (int k = 0; k < n; ++k) { const u32x4 v = *(const u32x4*)(P1 + (size_t)(m - k) * EVEN_MIX + c);
                const float f[8] = {bflo(v.x), bfhi(v.x), bflo(v.y), bfhi(v.y), bflo(v.z), bfhi(v.z), bflo(v.w), bfhi(v.w)};
#pragma unroll
                for (int e = 0; e < 8; ++e) { s[e] += f[e]; if (k == 0) cur[e] = f[e]; } }
            const float inv = 1.0f / (float)n;
#pragma unroll
            for (int e = 0; e < 8; ++e) o[e] = s[e] * inv - cur[e];
            u32x4 w4; w4.x = cvt_pk_bf16(o[0], o[1]); w4.y = cvt_pk_bf16(o[2], o[3]); w4.z = cvt_pk_bf16(o[4], o[5]); w4.w = cvt_pk_bf16(o[6], o[7]);
            *(u32x4*)(DU + (size_t)m * EVEN_MIX + c) = w4;
        } else {
            const int ch = 8 * (c8 - 64);
#pragma unroll
            for (int e = 0; e < 8; ++e) o[e] = cb[ch + e];
#pragma unroll
            for (int k = 0; k < 4; ++k) { const int dt = 3 - k; if (t - dt >= 0) {
                const u32x4 v = *(const u32x4*)(P1 + (size_t)(m - dt) * EVEN_MIX + POOLW + ch);
                const float f[8] = {bflo(v.x), bfhi(v.x), bflo(v.y), bfhi(v.y), bflo(v.z), bfhi(v.z), bflo(v.w), bfhi(v.w)};
#pragma unroll
                for (int e = 0; e < 8; ++e) o[e] += cw[k * LRUW + ch + e] * f[e]; } }
            u32x4 w4; w4.x = cvt_pk_bf16(o[0], o[1]); w4.y = cvt_pk_bf16(o[2], o[3]); w4.z = cvt_pk_bf16(o[4], o[5]); w4.w = cvt_pk_bf16(o[6], o[7]);
            *(u32x4*)(DU + (size_t)m * EVEN_MIX + POOLW + ch) = w4;
        }
    }
}
constexpr int SC_NCH = 32, SC_LEN = 64;
__device__ __forceinline__ void scan_phase(const Args& a, int pass) {
    const bf16_t* LOGA = (const bf16_t*)(a.ws + WS_BIG + B_LOGA); bf16_t* XL = (bf16_t*)(a.ws + WS_BIG + B_XL); const bf16_t* G = (const bf16_t*)(a.ws + WS_BIG + B_G);
    float* CA = (float*)(a.ws + WS_CARRY); float* CH = (float*)(a.ws + WS_CARRY + 1 * MiB);
    const int nitems = NBATCH * SC_NCH * (LRUW / 2);
    for (int it = blockIdx.x * 512 + threadIdx.x; it < nitems; it += gridDim.x * 512) {
        const int c2 = it % (LRUW / 2), chunk = (it / (LRUW / 2)) % SC_NCH, b = it / ((LRUW / 2) * SC_NCH), ch = 2 * c2;
        const size_t m0 = (size_t)b * SEQ + (size_t)chunk * SC_LEN;
        float h0 = 0.f, h1 = 0.f;
        if (pass == 1) {
            float A0 = 1.f, A1 = 1.f;
#pragma unroll 8
            for (int t = 0; t < SC_LEN; ++t) { const unsigned la = *(const unsigned*)(LOGA + (m0 + t) * LRUW + ch), xi = *(const unsigned*)(XL + (m0 + t) * EVEN_MIX + POOLW + ch);
                const float a0 = __builtin_amdgcn_exp2f(bflo(la)), a1 = __builtin_amdgcn_exp2f(bfhi(la));
                h0 = a0 * h0 + bflo(xi); h1 = a1 * h1 + bfhi(xi); A0 *= a0; A1 *= a1; }
            const size_t ci = ((size_t)b * SC_NCH + chunk) * LRUW + ch;
            *(f32x2*)(CA + ci) = (f32x2){A0, A1}; *(f32x2*)(CH + ci) = (f32x2){h0, h1};
        } else {
            for (int c = 0; c < chunk; ++c) { const size_t ci = ((size_t)b * SC_NCH + c) * LRUW + ch; const f32x2 A = *(const f32x2*)(CA + ci), H = *(const f32x2*)(CH + ci);
                h0 = A[0] * h0 + H[0]; h1 = A[1] * h1 + H[1]; }
#pragma unroll 8
            for (int t = 0; t < SC_LEN; ++t) { const unsigned la = *(const unsigned*)(LOGA + (m0 + t) * LRUW + ch), xi = *(const unsigned*)(XL + (m0 + t) * EVEN_MIX + POOLW + ch), gg = *(const unsigned*)(G + (m0 + t) * LRUW + ch);
                const float a0 = __builtin_amdgcn_exp2f(bflo(la)), a1 = __builtin_amdgcn_exp2f(bfhi(la));
                h0 = a0 * h0 + bflo(xi); h1 = a1 * h1 + bfhi(xi);
                *(unsigned*)(XL + (m0 + t) * EVEN_MIX + POOLW + ch) = cvt_pk_bf16(h0 * bflo(gg), h1 * bfhi(gg)); }
        }
    }
}
__device__ __forceinline__ void rmsrope_phase(const Args& a, int layer, int gw, int NGW, int lane) {
    const int j = layer >> 1;
    const float* DOWN = (const float*)(a.ws + WS_BIG + B_DOWN); bf16_t* CQ = (bf16_t*)(a.ws + WS_BIG + B_CQ); bf16_t* CKV = (bf16_t*)(a.ws + WS_BIG + B_CKV); bf16_t* KPE = (bf16_t*)(a.ws + WS_BIG + B_KPE);
    const float* qg = a.in[I_QNG] + (size_t)j * QL; const float* kg = a.in[I_KVNG] + (size_t)j * KVL;
    const float* COS = (const float*)(a.ws + WS_COS); const float* SIN = (const float*)(a.ws + WS_SIN);
    for (int m = gw; m < M; m += NGW) {
        const float* dr = DOWN + (size_t)m * ODD_IN_PAD;
        f32x2 q[3]; float ss = 0.f;
#pragma unroll
        for (int i = 0; i < 3; ++i) { q[i] = *(const f32x2*)(dr + 128 * i + 2 * lane); ss += q[i][0] * q[i][0] + q[i][1] * q[i][1]; }
        const float rq = 1.0f / sqrtf(wave_sum(ss) * (1.f / QL) + RMS_EPS);
#pragma unroll
        for (int i = 0; i < 3; ++i) { const f32x2 gg = *(const f32x2*)(qg + 128 * i + 2 * lane); *(unsigned*)(CQ + (size_t)m * QL + 128 * i + 2 * lane) = cvt_pk_bf16(q[i][0] * rq * gg[0], q[i][1] * rq * gg[1]); }
        const f32x4 kv = *(const f32x4*)(dr + QL + 4 * lane);
        const float rk = 1.0f / sqrtf(wave_sum((kv[0] * kv[0] + kv[1] * kv[1]) + (kv[2] * kv[2] + kv[3] * kv[3])) * (1.f / KVL) + RMS_EPS);
        const f32x4 gk = *(const f32x4*)(kg + 4 * lane);
        *(u32x2*)(CKV + (size_t)m * KVL + 4 * lane) = pack4(kv * rk * gk);
        const int i = lane & 31; const float x1 = dr[QL + KVL + i], x2 = dr[QL + KVL + 32 + i], c = COS[(size_t)m * 32 + i], s = SIN[(size_t)m * 32 + i];
        const float o = (lane < 32) ? (x1 * c - x2 * s) : (x1 * s + x2 * c);
        const float o_nb = __shfl_xor(o, 1);
        if ((lane & 1) == 0) *(unsigned*)(KPE + (size_t)m * ROPE + lane) = cvt_pk_bf16(o, o_nb);
    }
}
__device__ __forceinline__ void attn_naive_phase(const Args& a, float* lds_f, int gw, int NGW, int lane, int wave) {
    const bf16_t* Q = (const bf16_t*)(a.ws + WS_BIG + B_Q); const bf16_t* KN = (const bf16_t*)(a.ws + WS_BIG + B_KN); const bf16_t* KPE = (const bf16_t*)(a.ws + WS_BIG + B_KPE);
    const bf16_t* V = (const bf16_t*)(a.ws + WS_BIG + B_V); bf16_t* O = (bf16_t*)(a.ws + WS_BIG + B_O);
    float* qs = lds_f + wave * (192 + 2048); float* ps = qs + 192;
    for (int it = gw; it < M * NH; it += NGW) {
        const int h = it & 7, m = it >> 3, b = m / SEQ, t = m % SEQ, nk = 64 * (t / 64 + 1);
        for (int i = lane; i < DQK; i += 64) qs[i] = bf2f(Q[(size_t)m * (NH * DQK) + h * DQK + i]);
        asm volatile("s_waitcnt lgkmcnt(0)" ::: "memory");
        float mx = -3.0e38f;
        for (int kk = lane; kk < nk; kk += 64) { const size_t kr = (size_t)b * SEQ + kk; float s = 0.f;
            for (int d = 0; d < 128; d += 8) { const u32x4 v = *(const u32x4*)(KN + kr * D + h * 128 + d);
                s += qs[d] * bflo(v.x) + qs[d + 1] * bfhi(v.x) + qs[d + 2] * bflo(v.y) + qs[d + 3] * bfhi(v.y) + qs[d + 4] * bflo(v.z) + qs[d + 5] * bfhi(v.z) + qs[d + 6] * bflo(v.w) + qs[d + 7] * bfhi(v.w); }
            for (int d = 0; d < 64; d += 8) { const u32x4 v = *(const u32x4*)(KPE + kr * ROPE + d); const float* qq = qs + 128 + d;
                s += qq[0] * bflo(v.x) + qq[1] * bfhi(v.x) + qq[2] * bflo(v.y) + qq[3] * bfhi(v.y) + qq[4] * bflo(v.z) + qq[5] * bfhi(v.z) + qq[6] * bflo(v.w) + qq[7] * bfhi(v.w); }
            ps[kk] = s; mx = fmaxf(mx, s); }
        mx = wave_max(mx);
        float l = 0.f;
        for (int kk = lane; kk < nk; kk += 64) { const float e = __builtin_amdgcn_exp2f(ps[kk] - mx); ps[kk] = e; l += e; }
        l = wave_sum(l);
        asm volatile("s_waitcnt lgkmcnt(0)" ::: "memory");
        float o0 = 0.f, o1 = 0.f;
        for (int kk = 0; kk < nk; ++kk) { const unsigned v = *(const unsigned*)(V + ((size_t)b * SEQ + kk) * D + h * 128 + 2 * lane); const float p = ps[kk]; o0 += p * bflo(v); o1 += p * bfhi(v); }
        const float il = 1.0f / l;
        *(unsigned*)(O + (size_t)m * D + h * 128 + 2 * lane) = cvt_pk_bf16(o0 * il, o1 * il);
        asm volatile("s_waitcnt lgkmcnt(0)" ::: "memory");
    }
}

#ifndef GEMM_MASK
#define GEMM_MASK (USE_FAST_GEMM ? 0x3ff : 0)
#endif
template <int ID, class Epi>
__device__ __forceinline__ void run_gemm(LAS unsigned char* lds, const Gemm g, const Epi& E) {
    if constexpr ((GEMM_MASK >> ID) & 1) {
        pg8::StaticOrder S; S.init(g.M, g.N, (int)gridDim.x, (int)blockIdx.x);
        pg8::gemm_phase<Epi>(lds, g, S, E);
    } else {
        sgemm_phase<Epi>(g, E);
    }
}
constexpr int N_PHASES = 39;
__host__ __device__ constexpr int phase_base(int layer) { return layer == 0 ? 1 : layer == 1 ? 11 : layer == 2 ? 20 : 30; }
#if MK_ONE_LAUNCH
#define SEAM(k) do { if (lo <= (k) && (k) + 1 < hi) xcd_barrier(bar); } while (0)
#else
#define SEAM(k) do { } while (0)
#endif
#define IN(k) (lo <= (k) && (k) < hi)
template <int LAYER>
__device__ __forceinline__ void run_layer(const Args& args, LAS unsigned char* ldsl, unsigned char* lds, const XcdBarrier& bar, int lo, int hi, int gw, int NGW, int lane, int wave) {
    constexpr int base = phase_base(LAYER); constexpr bool even = (LAYER & 1) == 0; constexpr int j = LAYER >> 1;
    unsigned char* ws = args.ws; unsigned char* W = ws + WS_W; unsigned char* BIG = ws + WS_BIG; bf16_t* XB = (bf16_t*)(ws + WS_XB);
    const float* xres = (LAYER == 0) ? args.in[I_X] : (const float*)args.out;
    constexpr int nmix = even ? 6 : 5;
    if constexpr (even) {
        if (IN(base + 0)) { Gemm g{XB, (const bf16_t*)(W + W_IN), M, EVEN_IN, D, D, D, 0, 0}; EpiIn E{(bf16_t*)(BIG + B_P1), (bf16_t*)(BIG + B_G)}; run_gemm<0>(ldsl, g, E); }
        SEAM(base + 0);
        if (IN(base + 1)) convpool_phase(args, LAYER);
        SEAM(base + 1);
        if (IN(base + 2)) {
            { Gemm g{(const bf16_t*)(BIG + B_DU), (const bf16_t*)(W + W_POOL), M, POOLW, 256, EVEN_MIX, 256, 0, 256}; EpiPool E{(bf16_t*)(BIG + B_XL), args.in[I_POOLS] + (size_t)j * POOLW}; run_gemm<1>(ldsl, g, E); }
            { Gemm g{(const bf16_t*)(BIG + B_DU) + POOLW, (const bf16_t*)(W + W_GATE), M, 2048, 256, EVEN_MIX, 256, 1, 256};
              EpiGate E{(const bf16_t*)(BIG + B_DU), (bf16_t*)(BIG + B_LOGA), (bf16_t*)(BIG + B_XL), args.in[I_BA] + (size_t)j * LRUW, args.in[I_BX] + (size_t)j * LRUW, (const float*)(ws + WS_SP)}; run_gemm<2>(ldsl, g, E); }
        }
        SEAM(base + 2);
        if (IN(base + 3)) scan_phase(args, 1);
        SEAM(base + 3);
        if (IN(base + 4)) scan_phase(args, 2);
        SEAM(base + 4);
        if (IN(base + 5)) { Gemm g{(const bf16_t*)(BIG + B_XL), (const bf16_t*)(W + W_OUT), M, D, EVEN_MIX, EVEN_MIX, EVEN_MIX, 0, 0}; EpiRes E{xres, args.out}; run_gemm<3>(ldsl, g, E); }
        SEAM(base + 5);
    } else {
        if (IN(base + 0)) { Gemm g{XB, (const bf16_t*)(W + W_DOWN), M, ODD_IN_PAD, D, D, D, 0, 0}; EpiDown E{(float*)(BIG + B_DOWN)}; run_gemm<4>(ldsl, g, E); }
        SEAM(base + 0);
        if (IN(base + 1)) rmsrope_phase(args, LAYER, gw, NGW, lane);
        SEAM(base + 1);
        if (IN(base + 2)) {
            { Gemm g{(const bf16_t*)(BIG + B_CQ), (const bf16_t*)(W + W_QB), M, NH * DQK, QL, QL, QL, 0, 0}; EpiQ E{(bf16_t*)(BIG + B_Q), (const float*)(ws + WS_COS), (const float*)(ws + WS_SIN)}; run_gemm<5>(ldsl, g, E); }
            { Gemm g{(const bf16_t*)(BIG + B_CKV), (const bf16_t*)(W + W_KVB), M, 2048, KVL, KVL, KVL, 0, 0}; EpiKV E{(bf16_t*)(BIG + B_KN), (bf16_t*)(BIG + B_V)}; run_gemm<6>(ldsl, g, E); }
        }
        SEAM(base + 2);
        if (IN(base + 3)) attn_naive_phase(args, (float*)lds, gw, NGW, lane, wave);
        SEAM(base + 3);
        if (IN(base + 4)) { Gemm g{(const bf16_t*)(BIG + B_O), (const bf16_t*)(W + W_O), M, D, D, D, D, 0, 0}; EpiRes E{xres, args.out}; run_gemm<7>(ldsl, g, E); }
        SEAM(base + 4);
    }
    if (IN(base + nmix)) ln_phase(args, args.in[I_LNMG] + (size_t)LAYER * D, args.in[I_LNMB] + (size_t)LAYER * D, gw, NGW, lane);
    SEAM(base + nmix);
    if (IN(base + nmix + 1)) { Gemm g{XB, (const bf16_t*)(W + W_1), M, FF, D, D, D, 0, 0}; EpiRelu2 E{(bf16_t*)(BIG + B_H)}; run_gemm<8>(ldsl, g, E); }
    SEAM(base + nmix + 1);
    if (IN(base + nmix + 2)) { Gemm g{(const bf16_t*)(BIG + B_H), (const bf16_t*)(W + W_2), M, D, FF, FF, FF, 0, 0}; EpiRes E{(const float*)args.out, args.out}; run_gemm<9>(ldsl, g, E); }
    SEAM(base + nmix + 2);
    if (IN(base + nmix + 3)) { ln_phase(args, args.in[I_LNFG] + (size_t)LAYER * D, args.in[I_LNFB] + (size_t)LAYER * D, gw, NGW, lane);
        if constexpr (LAYER < 3) convert_weights(args, LAYER + 1, (float*)lds + wave * 4096, gw, NGW, lane); }
    if constexpr (LAYER < 3) SEAM(base + nmix + 3);
}
__global__ void __launch_bounds__(NWAVES * 64, 2) mega_fwd(Args args) {
    extern __shared__ __attribute__((aligned(16))) unsigned char lds[];
    LAS unsigned char* ldsl = (LAS unsigned char*)lds;
    const int tid = threadIdx.x, lane = tid & 63, wave = __builtin_amdgcn_readfirstlane(tid >> 6);
    const int gw = blockIdx.x * NWAVES + wave, NGW = gridDim.x * NWAVES;
    unsigned char* ws = args.ws;
    volatile LAS unsigned* MISC = (volatile LAS unsigned*)(ldsl + MISC_OFF);
    for (int u = tid; u < (LDS_BYTES - LDSCTL_OFF) / 4; u += NWAVES * 64) ((LAS unsigned*)(ldsl + LDSCTL_OFF))[u] = 0u;
    __syncthreads();
    XcdBarrier bar; bar.bar = (unsigned*)(ws + WS_CTL) + CW_BAR; bar.x = 0; bar.st = nullptr;
#if MK_ONE_LAUNCH
    bar = xcd_barrier_post((unsigned*)(ws + WS_CTL) + CW_BAR, MISC + 8);
#else
    (void)MISC;
#endif
    const int lo = args.ph_lo, hi = args.ph_hi;
    if (IN(0)) { convert_weights(args, 0, (float*)lds + wave * 4096, gw, NGW, lane); prologue_phase(args, gw, NGW, lane); }
    SEAM(0);
    run_layer<0>(args, ldsl, lds, bar, lo, hi, gw, NGW, lane, wave);
    run_layer<1>(args, ldsl, lds, bar, lo, hi, gw, NGW, lane, wave);
    run_layer<2>(args, ldsl, lds, bar, lo, hi, gw, NGW, lane, wave);
    run_layer<3>(args, ldsl, lds, bar, lo, hi, gw, NGW, lane, wave);
}
#undef IN
#undef SEAM

extern "C" void kernel_launch(void* const* d_in, const int* in_sizes, int n_in, void* d_out, int out_size, void* d_ws, size_t ws_size, hipStream_t stream) {
    static int grid = 0;
    if (grid == 0) {
        if (n_in != 25 || in_sizes[0] != M * D || out_size != M * D || ws_size < WS_END) { fprintf(stderr, "kernel_launch: unexpected shapes: n_in %d in0 %d out %d ws %zu\n", n_in, n_in > 0 ? in_sizes[0] : -1, out_size, ws_size); grid = -1; return; }
        int dev = 0, cus = 0, per_cu = 0;
        if (hipGetDevice(&dev) != hipSuccess || hipDeviceGetAttribute(&cus, hipDeviceAttributeMultiprocessorCount, dev) != hipSuccess) { grid = -1; return; }
        if (hipFuncSetAttribute((const void*)mega_fwd, hipFuncAttributeMaxDynamicSharedMemorySize, LDS_BYTES) != hipSuccess) { fprintf(stderr, "kernel_launch: hipFuncSetAttribute failed\n"); grid = -1; return; }
        if (hipOccupancyMaxActiveBlocksPerMultiprocessor(&per_cu, (const void*)mega_fwd, NWAVES * 64, LDS_BYTES) != hipSuccess || per_cu < 1) { fprintf(stderr, "kernel_launch: occupancy query says %d blocks per CU\n", per_cu); per_cu = 1; }
        (void)hipGetLastError();
        grid = cus;
    }
    if (grid < 0) return;
    (void)hipMemsetAsync((char*)d_ws + WS_CTL, 0, CTL_ZERO_BYTES, stream);
    Args a{};
    for (int i = 0; i < 25; ++i) a.in[i] = (const float*)d_in[i];
    a.out = (float*)d_out; a.ws = (unsigned char*)d_ws;
#if MK_ONE_LAUNCH
    a.ph_lo = 0; a.ph_hi = N_PHASES;
    void* kargs[] = {&a};
    hipError_t e = hipLaunchCooperativeKernel((const void*)mega_fwd, dim3(grid), dim3(NWAVES * 64), kargs, LDS_BYTES, stream);
    if (e != hipSuccess) fprintf(stderr, "kernel_launch: cooperative launch failed: %s (grid %d)\n", hipGetErrorString(e), grid);
#else
    for (int ph = 0; ph < N_PHASES; ++ph) { a.ph_lo = ph; a.ph_hi = ph + 1; hipLaunchKernelGGL(mega_fwd, dim3(grid), dim3(NWAVES * 64), LDS_BYTES, stream, a); }
#endif
}
```

```cpp
#include <hip/hip_runtime.h>
#include <cstdio>
#include <cstdint>
#include <cmath>

#ifndef MK_ONE_LAUNCH
#define MK_ONE_LAUNCH 1
#endif
#ifndef USE_NAIVE_ATTN
#define USE_NAIVE_ATTN 0
#endif
#ifndef USE_FAST_GEMM
#define USE_FAST_GEMM 1
#endif

#define LAS __attribute__((address_space(3)))
#define GAS __attribute__((address_space(1)))
typedef unsigned short bf16_t;
typedef short bf16x8 __attribute__((ext_vector_type(8)));
typedef float f32x4 __attribute__((ext_vector_type(4)));
typedef float f32x2 __attribute__((ext_vector_type(2)));
typedef float f32x16 __attribute__((ext_vector_type(16)));
typedef unsigned u32x4 __attribute__((ext_vector_type(4)));
typedef unsigned u32x2 __attribute__((ext_vector_type(2)));

constexpr int M = 16384, D = 1024, SEQ = 2048, NBATCH = 8, FF = 4096;
constexpr int POOLW = 512, LRUW = 1024, EVEN_IN = 2560, EVEN_MIX = 1536;
constexpr int QL = 384, KVL = 256, ROPE = 64, ODD_IN = 704, ODD_IN_PAD = 768;
constexpr int NH = 8, DQK = 192, DV = 128;
constexpr float ALPHA = 1.681792830507429f;
constexpr float LN_EPS = 1e-5f, RMS_EPS = 1e-6f;
constexpr float LOG2E = 1.4426950408889634f;
constexpr float QSCALE = 0.07216878364870322f * LOG2E;

constexpr size_t MiB = 1u << 20;
constexpr size_t WS_CTL = 0, CTL_ZERO_BYTES = 1 * MiB;
constexpr size_t WS_COS = 1 * MiB, WS_SIN = 3 * MiB;
constexpr size_t WS_CARRY = 5 * MiB;
constexpr size_t WS_SP = 7 * MiB;
constexpr size_t WS_W = 8 * MiB;
constexpr size_t WS_XB = 36 * MiB;
constexpr size_t WS_BIG = 68 * MiB;
constexpr size_t W_IN = 0, W_POOL = 5 * MiB, W_GATE = 5 * MiB + 256 * 1024, W_OUT = 6 * MiB + 256 * 1024;
constexpr size_t W_DOWN = 0, W_QB = 1 * MiB + 512 * 1024, W_KVB = 3 * MiB, W_O = 4 * MiB;
constexpr size_t W_1 = 10 * MiB, W_2 = 18 * MiB;
constexpr size_t B_P1 = 0, B_LOGA = 0, B_G = 48 * MiB, B_DU = 80 * MiB, B_XL = 128 * MiB;
constexpr size_t B_DOWN = 0, B_Q = 0, B_CQ = 48 * MiB, B_CKV = 60 * MiB, B_KPE = 68 * MiB, B_KN = 72 * MiB, B_V = 104 * MiB, B_O = 136 * MiB;
constexpr size_t B_H = 0;
constexpr size_t WS_END = 256 * MiB;
static_assert(WS_BIG + B_XL + (size_t)M * EVEN_MIX * 2 <= WS_END && WS_BIG + B_O + (size_t)M * D * 2 <= WS_END && WS_BIG + (size_t)M * FF * 2 <= WS_END, "ws map");

constexpr int CW_BAR = 4096;

constexpr int RING_BYTES = 131072;
constexpr int LDSCTL_OFF = RING_BYTES, MISC_OFF = LDSCTL_OFF + 320;
constexpr int LDS_BYTES = 147456;
constexpr int NWAVES = 8;

typedef __bf16 bf16x2_t __attribute__((ext_vector_type(2)));
__device__ __forceinline__ unsigned cvt_pk_bf16(float lo, float hi) { const f32x2 v = {lo, hi}; const bf16x2_t b = __builtin_convertvector(v, bf16x2_t); return __builtin_bit_cast(unsigned, b); }
__device__ __forceinline__ float bf2f(unsigned short u) { return __uint_as_float((unsigned)u << 16); }
__device__ __forceinline__ float bflo(unsigned u) { return __uint_as_float(u << 16); }
__device__ __forceinline__ float bfhi(unsigned u) { return __uint_as_float(u & 0xffff0000u); }
__device__ __forceinline__ u32x2 pack4(f32x4 v) { u32x2 w; w.x = cvt_pk_bf16(v[0], v[1]); w.y = cvt_pk_bf16(v[2], v[3]); return w; }
__device__ __forceinline__ float wave_sum(float v) {
#pragma unroll
    for (int o = 1; o < 64; o <<= 1) v += __shfl_xor(v, o);
    return v;
}
__device__ __forceinline__ float wave_max(float v) {
#pragma unroll
    for (int o = 1; o < 64; o <<= 1) v = fmaxf(v, __shfl_xor(v, o));
    return v;
}
__device__ __forceinline__ float sigmoidf_(float x) { return __builtin_amdgcn_rcpf(1.0f + __builtin_amdgcn_exp2f(-x * LOG2E)); }
__device__ __forceinline__ float gelu_tanh(float x) {
    const float u = 0.7978845608028654f * (x + 0.044715f * x * x * x);
    const float t = __builtin_amdgcn_exp2f(2.0f * LOG2E * u);
    const float th = 1.0f - 2.0f * __builtin_amdgcn_rcpf(t + 1.0f);
    return 0.5f * x * (1.0f + th);
}

struct Unit { int pm, pn; };
struct Gemm { const bf16_t* A; const bf16_t* Bt; int M, N, K, lda, ldb, ashift, amul; };

template <class Epi>
__device__ __forceinline__ void sgemm_phase(const Gemm g, const Epi& E) {
    const int tid = threadIdx.x, lane = tid & 63, wave = tid >> 6, r = lane & 31, hi = lane >> 5;
    const int nM = g.M / 256, nN = g.N / 256, nU = nM * nN;
    for (int u = blockIdx.x; u < nU; u += gridDim.x) {
        const int pm = u / nN, pn = u % nN;
        const bf16_t* A = g.A + (size_t)(pm * 256 + wave * 32 + r) * g.lda + (size_t)((pn >> g.ashift) * g.amul) + 8 * hi;
        const bf16_t* B = g.Bt + (size_t)(pn * 256 + r) * g.ldb + 8 * hi;
        for (int cb = 0; cb < 4; ++cb) {
            f32x16 acc0 = {}, acc1 = {};
            const bf16_t* B0 = B + (size_t)(cb * 32) * g.ldb;
            const bf16_t* B1 = B0 + (size_t)128 * g.ldb;
            for (int k0 = 0; k0 < g.K; k0 += 16) {
                const bf16x8 a = *(const bf16x8*)(A + k0);
                const bf16x8 b0 = *(const bf16x8*)(B0 + k0);
                const bf16x8 b1 = *(const bf16x8*)(B1 + k0);
                acc0 = __builtin_amdgcn_mfma_f32_32x32x16_bf16(b0, a, acc0, 0, 0, 0);
                acc1 = __builtin_amdgcn_mfma_f32_32x32x16_bf16(b1, a, acc1, 0, 0, 0);
            }
            const int row = pm * 256 + wave * 32 + r;
#pragma unroll
            for (int q = 0; q < 4; ++q) {
                const f32x4 v0 = {acc0[4 * q], acc0[4 * q + 1], acc0[4 * q + 2], acc0[4 * q + 3]};
                const f32x4 v1 = {acc1[4 * q], acc1[4 * q + 1], acc1[4 * q + 2], acc1[4 * q + 3]};
                E(row, pn, cb * 32 + 8 * q + 4 * hi, v0, v1);
            }
        }
    }
}

struct EpiIn {
    bf16_t* P1; bf16_t* G;
    __device__ __forceinline__ void operator()(int row, int pn, int cc, f32x4 v0, f32x4 v1) const {
        if (pn < 6) { bf16_t* p = P1 + (size_t)row * EVEN_MIX + pn * 256 + cc; *(u32x2*)p = pack4(v0); *(u32x2*)(p + 128) = pack4(v1); }
        else { bf16_t* p = G + (size_t)row * LRUW + (pn - 6) * 256 + cc;
#pragma unroll
            for (int e = 0; e < 4; ++e) { v0[e] = gelu_tanh(v0[e]); v1[e] = gelu_tanh(v1[e]); }
            *(u32x2*)p = pack4(v0); *(u32x2*)(p + 128) = pack4(v1); }
    }
};
struct EpiPool {
    bf16_t* XL; const float* scale;
    __device__ __forceinline__ void operator()(int row, int pn, int cc, f32x4 v0, f32x4 v1) const {
        const int c = pn * 256 + cc; const f32x4 s0 = *(const f32x4*)(scale + c), s1 = *(const f32x4*)(scale + c + 128);
        bf16_t* p = XL + (size_t)row * EVEN_MIX + c; *(u32x2*)p = pack4(v0 * s0); *(u32x2*)(p + 128) = pack4(v1 * s1);
    }
};
struct EpiGate {
    const bf16_t* DU; bf16_t* LOGA; bf16_t* XL; const float* b_a; const float* b_x; const float* sp8;
    __device__ __forceinline__ void operator()(int row, int pn, int cc, f32x4 v0, f32x4 v1) const {
        const int ch = pn * 128 + cc;
        const f32x4 ba = *(const f32x4*)(b_a + ch), bx = *(const f32x4*)(b_x + ch), sp = *(const f32x4*)(sp8 + ch);
        const u32x2 uu = *(const u32x2*)(DU + (size_t)row * EVEN_MIX + POOLW + ch);
        const float uf[4] = {bflo(uu.x), bfhi(uu.x), bflo(uu.y), bfhi(uu.y)};
        f32x4 la, xi;
#pragma unroll
        for (int e = 0; e < 4; ++e) {
            const float rg = sigmoidf_(v0[e] + ba[e]), ig = sigmoidf_(v1[e] + bx[e]);
            const float log_a = rg * sp[e];
            const float mult = sqrtf(fmaxf(-expm1f(2.0f * log_a), 0.0f));
            la[e] = log_a * LOG2E; xi[e] = mult * (ig * uf[e]);
        }
        *(u32x2*)(LOGA + (size_t)row * LRUW + ch) = pack4(la);
        *(u32x2*)(XL + (size_t)row * EVEN_MIX + POOLW + ch) = pack4(xi);
    }
};
struct EpiRes {
    const float* res; float* out;
    __device__ __forceinline__ void operator()(int row, int pn, int cc, f32x4 v0, f32x4 v1) const {
        const size_t o = (size_t)row * D + pn * 256 + cc;
        const f32x4 r0 = *(const f32x4*)(res + o), r1 = *(const f32x4*)(res + o + 128);
        *(f32x4*)(out + o) = r0 * ALPHA + v0; *(f32x4*)(out + o + 128) = r1 * ALPHA + v1;
    }
};
struct EpiRelu2 {
    bf16_t* H;
    __device__ __forceinline__ void operator()(int row, int pn, int cc, f32x4 v0, f32x4 v1) const {
#pragma unroll
        for (int e = 0; e < 4; ++e) { const float a = fmaxf(v0[e], 0.f), b = fmaxf(v1[e], 0.f); v0[e] = a * a; v1[e] = b * b; }
        bf16_t* p = H + (size_t)row * FF + pn * 256 + cc; *(u32x2*)p = pack4(v0); *(u32x2*)(p + 128) = pack4(v1);
    }
};
struct EpiDown {
    float* DOWN;
    __device__ __forceinline__ void operator()(int row, int pn, int cc, f32x4 v0, f32x4 v1) const {
        float* p = DOWN + (size_t)row * ODD_IN_PAD + pn * 256 + cc; *(f32x4*)p = v0; *(f32x4*)(p + 128) = v1;
    }
};
struct EpiQ {
    bf16_t* Q; const float* COS; const float* SIN;
    __device__ __forceinline__ void operator()(int row, int pn, int cc, f32x4 v0, f32x4 v1) const {
        bf16_t* qr = Q + (size_t)row * (NH * DQK);
        if (pn < 4) { *(u32x2*)(qr + (2 * pn) * DQK + cc) = pack4(v0 * QSCALE); *(u32x2*)(qr + (2 * pn + 1) * DQK + cc) = pack4(v1 * QSCALE); }
        else { const int h = 4 * (pn - 4) + (cc >> 5), i = cc & 31;
            const f32x4 c = *(const f32x4*)(COS + (size_t)row * 32 + i), s = *(const f32x4*)(SIN + (size_t)row * 32 + i);
            const f32x4 o1 = (v0 * c - v1 * s) * QSCALE, o2 = (v0 * s + v1 * c) * QSCALE;
            *(u32x2*)(qr + h * DQK + 128 + i) = pack4(o1); *(u32x2*)(qr + h * DQK + 160 + i) = pack4(o2); }
    }
};
struct EpiKV {
    bf16_t* KN; bf16_t* V;
    __device__ __forceinline__ void operator()(int row, int pn, int cc, f32x4 v0, f32x4 v1) const {
        bf16_t* p = (pn < 4 ? KN : V) + (size_t)row * D + (pn & 3) * 256 + cc; *(u32x2*)p = pack4(v0); *(u32x2*)(p + 128) = pack4(v1);
    }
};

namespace pg8 {
constexpr int BM = 256, BK = 64, HALF = 128, HTB = HALF * BK * 2, STAGE_BYTES = 8 * HTB, NXCD = 8, WGM = 8;
__host__ __device__ __forceinline__ int lds_byte(int r, int c) { const int st = (r >> 4) * 2 + (c >> 5), rr = r & 15, cc = c & 31, ob = rr * 64 + cc * 2; return st * 1024 + (ob ^ (((ob >> 9) & 1) << 5)); }
__host__ __device__ __forceinline__ void stage_rc(int b, int& R, int& C) { const int st = b / 1024, sb = b % 1024, swz = sb ^ (((sb >> 9) & 1) << 5); R = (st >> 1) * 16 + swz / 64; C = (st & 1) * 32 + (swz % 64) / 2; }
struct StaticOrder {
    int nM, nN, nwg, G, c;
    __device__ void init(int M_, int N_, int G_, int c_) { nM = M_ / BM; nN = N_ / BM; nwg = nM * nN; G = G_; c = c_; }
    __device__ bool next(int i, Unit& u) const {
        const long L = (long)i * G + c; if (L >= nwg) return false;
        int wgid = (int)L; { const int q = nwg / NXCD, r = nwg % NXCD, xcd = wgid % NXCD, off = wgid / NXCD; wgid = (xcd < r ? xcd * (q + 1) : r * (q + 1) + (xcd - r) * q) + off; }
        const int nig = WGM * nN, gid = wgid / nig, fm = gid * WGM, gsz = (nM - fm) < WGM ? (nM - fm) : WGM;
        u.pm = fm + ((wgid % nig) % gsz); u.pn = (wgid % nig) / gsz; return true;
    }
};
template <class Epi>
__device__ __forceinline__ void gemm_phase(LAS unsigned char* lds, const Gemm g, const StaticOrder& S, const Epi& E) {
    int tid_ = threadIdx.x; asm volatile("" : "+v"(tid_));
    const int tid = tid_, wid = __builtin_amdgcn_readfirstlane(tid >> 6), lane = tid & 63, wr = wid >> 2, wc = wid & 3, fr = lane & 15, fq = lane >> 4;
    const int K = g.K, nt = K / BK;
    unsigned voffA[2], voffB[2];
#pragma unroll
    for (int i = 0; i < 2; ++i) { int R, C; stage_rc(tid * 16 + i * 8192, R, C); voffA[i] = (unsigned)(R * g.lda + C) * 2u; voffB[i] = (unsigned)(R * g.ldb + C) * 2u; }
    const size_t kstep = (size_t)(BK * 2);
    const size_t hstepA = (size_t)HALF * g.lda * 2, hstepB = (size_t)HALF * g.ldb * 2;
    const size_t tstepA = 2 * hstepA, tstepB = 2 * hstepB;
    const unsigned ldsw = (unsigned)wid * 1024u;
    const int aoff = lds_byte(wr * 64 + fr, fq * 8), boff = lds_byte(wc * 32 + fr, fq * 8);
#define PG8_SA(b, h) (((b) * 2 + (h)) * HTB)
#define PG8_SB(b, h) ((4 + (b) * 2 + (h)) * HTB)
#define PG8_STAGE(bufoff, gbase, voff) do { _Pragma("unroll") for (int _i = 0; _i < 2; ++_i) \
        __builtin_amdgcn_global_load_lds((const unsigned*)((const char*)(gbase) + (voff)[_i]), (LAS unsigned*)(lds + (bufoff) + ldsw + _i * 8192), 16, 0, 0); } while (0)
#define PG8_LDA(dst, b, h) do { _Pragma("unroll") for (int m = 0; m < 4; ++m) _Pragma("unroll") for (int k = 0; k < 2; ++k) dst[m][k] = *(const LAS bf16x8*)(lds + PG8_SA(b, h) + aoff + m * 2048 + k * 1024); } while (0)
#define PG8_LDB(dst, b, h) do { _Pragma("unroll") for (int n = 0; n < 2; ++n) _Pragma("unroll") for (int k = 0; k < 2; ++k) dst[n][k] = *(const LAS bf16x8*)(lds + PG8_SB(b, h) + boff + n * 2048 + k * 1024); } while (0)
#define PG8_MMA(ai, bj, At, Bt) do { __builtin_amdgcn_s_setprio(1); _Pragma("unroll") for (int m = 0; m < 4; ++m) _Pragma("unroll") for (int n = 0; n < 2; ++n) _Pragma("unroll") for (int k = 0; k < 2; ++k) \
        acc[ai][bj][m][n] = __builtin_amdgcn_mfma_f32_16x16x32_bf16(Bt[n][k], At[m][k], acc[ai][bj][m][n], 0, 0, 0); __builtin_amdgcn_s_setprio(0); } while (0)
#define PG8_WAIT_V(n) asm volatile("s_waitcnt vmcnt(" #n ")" ::: "memory")
#define PG8_WAIT_L(n) asm volatile("s_waitcnt lgkmcnt(" #n ")" ::: "memory")
#define PG8_BAR __builtin_amdgcn_s_barrier()
#define PG8_SCHED __builtin_amdgcn_sched_barrier(0)
#define PG8_APTR(u) ((const char*)g.A + (size_t)(u).pm * tstepA + (size_t)(((u).pn >> g.ashift) * g.amul) * 2)
#define PG8_BPTR(u) ((const char*)g.Bt + (size_t)(u).pn * tstepB)
    Unit cur, nxt; int ui = 0;
    if (!S.next(0, cur)) return;
    f32x4 acc[2][2][4][2];
#pragma unroll
    for (int a = 0; a < 2; ++a)
#pragma unroll
        for (int b = 0; b < 2; ++b)
#pragma unroll
            for (int m = 0; m < 4; ++m)
#pragma unroll
                for (int n = 0; n < 2; ++n) acc[a][b][m][n] = (f32x4){0.f, 0.f, 0.f, 0.f};
    bf16x8 At[4][2], B0[2][2], B1[2][2];
    const char* cA = PG8_APTR(cur); const char* cB = PG8_BPTR(cur);
    PG8_STAGE(PG8_SB(0, 0), cB, voffB); PG8_STAGE(PG8_SB(0, 1), cB + hstepB, voffB); PG8_STAGE(PG8_SA(0, 0), cA, voffA); PG8_STAGE(PG8_SA(0, 1), cA + hstepA, voffA);
    if (wr == 1) PG8_BAR;
    PG8_WAIT_V(2); PG8_BAR;
    PG8_STAGE(PG8_SB(1, 0), cB + kstep, voffB); PG8_STAGE(PG8_SA(1, 0), cA + kstep, voffA); PG8_STAGE(PG8_SB(1, 1), cB + hstepB + kstep, voffB);
    PG8_WAIT_V(6); PG8_BAR;
    for (;;) {
        const bool has_next = S.next(ui + 1, nxt);
        const char* nA = has_next ? PG8_APTR(nxt) : cA; const char* nB = has_next ? PG8_BPTR(nxt) : cB;
#pragma unroll 1
        for (int t = 0; t < nt; t += 2) {
            const bool last = (t == nt - 2);
            const char* a1 = cA + (size_t)(t + 1) * kstep;
            const char* a2 = last ? nA : cA + (size_t)(t + 2) * kstep; const char* b2 = last ? nB : cB + (size_t)(t + 2) * kstep;
            const char* a3 = a2 + kstep; const char* b3 = b2 + kstep;
            PG8_LDB(B0, 0, 0); PG8_LDB(B1, 0, 1); PG8_SCHED; PG8_LDA(At, 0, 0); PG8_STAGE(PG8_SA(1, 1), a1 + hstepA, voffA);
            PG8_WAIT_V(8); PG8_WAIT_L(0); PG8_BAR; PG8_MMA(0, 0, At, B0); PG8_MMA(0, 1, At, B1); PG8_BAR; PG8_SCHED;
            PG8_LDA(At, 0, 1); PG8_STAGE(PG8_SB(0, 0), b2, voffB); PG8_STAGE(PG8_SB(0, 1), b2 + hstepB, voffB); PG8_STAGE(PG8_SA(0, 0), a2, voffA);
            PG8_WAIT_V(8); PG8_WAIT_L(0); PG8_BAR; PG8_MMA(1, 0, At, B0); PG8_MMA(1, 1, At, B1); PG8_BAR; PG8_SCHED;
            PG8_LDB(B0, 1, 0); PG8_LDB(B1, 1, 1); PG8_SCHED; PG8_LDA(At, 1, 0); PG8_STAGE(PG8_SA(0, 1), a2 + hstepA, voffA);
            PG8_WAIT_V(8); PG8_WAIT_L(0); PG8_BAR; PG8_MMA(0, 0, At, B0); PG8_MMA(0, 1, At, B1); PG8_BAR; PG8_SCHED;
            PG8_LDA(At, 1, 1); PG8_STAGE(PG8_SB(1, 0), b3, voffB); PG8_STAGE(PG8_SB(1, 1), b3 + hstepB, voffB); PG8_STAGE(PG8_SA(1, 0), a3, voffA);
            PG8_WAIT_V(8); PG8_WAIT_L(0); PG8_BAR; PG8_MMA(1, 0, At, B0); PG8_MMA(1, 1, At, B1); PG8_BAR; PG8_SCHED;
        }
        if (wr == 0) PG8_BAR;
        {
#pragma unroll
            for (int ai = 0; ai < 2; ++ai)
#pragma unroll
                for (int m = 0; m < 4; ++m) { const int row = cur.pm * BM + ai * HALF + wr * 64 + m * 16 + fr;
#pragma unroll
                    for (int n = 0; n < 2; ++n) E(row, cur.pn, wc * 32 + n * 16 + 4 * fq, acc[ai][0][m][n], acc[ai][1][m][n]);
                    asm volatile("" ::: "memory"); }
        }
        if (!has_next) break;
#pragma unroll
        for (int a = 0; a < 2; ++a)
#pragma unroll
            for (int b = 0; b < 2; ++b)
#pragma unroll
                for (int m = 0; m < 4; ++m)
#pragma unroll
                    for (int n = 0; n < 2; ++n) acc[a][b][m][n] = (f32x4){0.f, 0.f, 0.f, 0.f};
        cur = nxt; cA = nA; cB = nB; ++ui;
        if (wr == 1) PG8_BAR;
    }
    PG8_WAIT_V(0);
    PG8_BAR;
#undef PG8_SA
#undef PG8_SB
#undef PG8_STAGE
#undef PG8_LDA
#undef PG8_LDB
#undef PG8_MMA
#undef PG8_WAIT_V
#undef PG8_WAIT_L
#undef PG8_BAR
#undef PG8_SCHED
#undef PG8_APTR
#undef PG8_BPTR
}
}

#define XB_TMO      128
#define XB_XCNT(j)  (256  + 64 * (j))
#define XB_XSUB(j)  (1280 + 64 * (j))
#define XB_XGEN(j)  (2304 + 64 * (j))
#define XB_TOP      3328
#define XB_TOPGEN   3392
#define XCD_BAR_WORDS 3456
#define XB_SPIN_CAP (1u << 18)
__device__ __forceinline__ unsigned xb_ld(unsigned* p)              { return __hip_atomic_load(p, __ATOMIC_RELAXED, __HIP_MEMORY_SCOPE_AGENT); }
__device__ __forceinline__ unsigned xb_add(unsigned* p, unsigned v) { return __hip_atomic_fetch_add(p, v, __ATOMIC_RELAXED, __HIP_MEMORY_SCOPE_AGENT); }
__device__ __forceinline__ unsigned xb_xcc_id() { return (unsigned)__builtin_amdgcn_s_getreg((3 << 11) | 20) & 0xFu; }
#define XB_SPIN(cond, bar) do { unsigned _sp = 0; while (cond) { __builtin_amdgcn_s_sleep(1); \
    if ((++_sp & 255u) == 0u) { if (xb_ld(&(bar)[XB_TMO])) break; if (_sp > XB_SPIN_CAP) { atomicAdd(&(bar)[XB_TMO], 1u); break; } } } } while (0)
struct XcdBarrier { unsigned* bar; unsigned x; volatile LAS unsigned* st; };
__device__ __forceinline__ XcdBarrier xcd_barrier_post(unsigned* bar, volatile LAS unsigned* st) {
    XcdBarrier b; b.bar = bar; b.x = xb_xcc_id(); b.st = st;
    if (threadIdx.x == 0) (void)xb_add(&bar[XB_XCNT(b.x)], 1u);
    return b;
}
__device__ __forceinline__ void xcd_barrier_complete(unsigned* bar, unsigned x, unsigned& nloc, unsigned& nx) {
    const unsigned G = gridDim.x * gridDim.y * gridDim.z;
    unsigned sum, cnt, mine, sp = 0u;
    for (;;) {
        sum = 0u; cnt = 0u; mine = 0u;
#pragma unroll
        for (unsigned j = 0; j < 16; ++j) { const unsigned c = xb_ld(&bar[XB_XCNT(j)]); sum += c; cnt += (c > 0u) ? 1u : 0u; mine = (j == x) ? c : mine; }
        if (sum == G) break;
        __builtin_amdgcn_s_sleep(1);
        if ((++sp & 255u) == 0u) { if (xb_ld(&bar[XB_TMO])) break; if (sp > XB_SPIN_CAP) { atomicAdd(&bar[XB_TMO], 1u); break; } }
    }
    nloc = mine > 0u ? mine : 1u; nx = cnt > 0u ? cnt : 1u;
}
__device__ __forceinline__ void xcd_barrier(const XcdBarrier& b) {
    asm volatile("s_waitcnt vmcnt(0)" ::: "memory");
    __syncthreads();
    if (threadIdx.x == 0) {
        unsigned* bar = b.bar;
        __builtin_amdgcn_s_waitcnt(0);
        unsigned nloc = b.st[0], nx = b.st[1];
        if (nloc == 0u) { xcd_barrier_complete(bar, b.x, nloc, nx); b.st[0] = nloc; b.st[1] = nx; }
        const unsigned old = xb_add(&bar[XB_XSUB(b.x)], 1u);
        const unsigned gen = old / nloc;
        if (old + 1u == (gen + 1u) * nloc) {
            __builtin_amdgcn_fence(__ATOMIC_RELEASE, "agent");
            asm volatile("s_waitcnt vmcnt(0)" ::: "memory");
            const unsigned og = xb_add(&bar[XB_TOP], 1u);
            const unsigned tg = og / nx;
            if (og + 1u == (tg + 1u) * nx) xb_add(&bar[XB_TOPGEN], 1u);
            else XB_SPIN(xb_ld(&bar[XB_TOPGEN]) == tg, bar);
            __builtin_amdgcn_fence(__ATOMIC_ACQUIRE, "agent");
            xb_add(&bar[XB_XGEN(b.x)], 1u);
            asm volatile("s_waitcnt vmcnt(0)" ::: "memory");
        } else {
            XB_SPIN(xb_ld(&bar[XB_XGEN(b.x)]) == gen, bar);
            __builtin_amdgcn_fence(__ATOMIC_ACQUIRE, "agent");
            asm volatile("s_waitcnt vmcnt(0)" ::: "memory");
        }
    }
    __syncthreads();
}

struct Args {
    const float* in[25];
    float* out; unsigned char* ws;
    int ph_lo, ph_hi;
};
enum { I_X = 0, I_POS, I_LNMG, I_LNMB, I_LNFG, I_LNFB, I_EWIN, I_POOLW, I_POOLS, I_CONVW, I_CONVB, I_WA, I_BA, I_WX, I_BX, I_LAM, I_EWOUT,
       I_WDOWN, I_QNG, I_KVNG, I_WQB, I_WKVB, I_WO, I_W1, I_W2 };

__device__ __forceinline__ void transpose_item(const float* src, int ld_src, int src_row0, int src_col0, bf16_t* dst, int ld_dst, int dst_row0, int dst_col0, bool zero, float* scr, int lane) {
    if (!zero) {
#pragma unroll 8
        for (int i = 0; i < 32; ++i) { const int kk = 2 * i + (lane >> 5); scr[kk * 33 + (lane & 31)] = src[(size_t)(src_row0 + kk) * ld_src + src_col0 + (lane & 31)]; }
    }
    asm volatile("s_waitcnt lgkmcnt(0)" ::: "memory");
    const int c = lane & 7;
#pragma unroll
    for (int j = 0; j < 4; ++j) { const int n = (lane >> 3) + 8 * j; const float* s = scr + (8 * c) * 33 + n;
        u32x4 o = {0u, 0u, 0u, 0u};
        if (!zero) { o.x = cvt_pk_bf16(s[0 * 33], s[1 * 33]); o.y = cvt_pk_bf16(s[2 * 33], s[3 * 33]); o.z = cvt_pk_bf16(s[4 * 33], s[5 * 33]); o.w = cvt_pk_bf16(s[6 * 33], s[7 * 33]); }
        *(u32x4*)(dst + (size_t)(dst_row0 + n) * ld_dst + dst_col0 + 8 * c) = o; }
    asm volatile("s_waitcnt lgkmcnt(0)" ::: "memory");
}
__device__ __forceinline__ void conv_plain(const float* src, int K, int N, int Npad, bf16_t* dst, float* scr, int gw, int NGW, int lane) {
    const int nblk = Npad / 32, items = (K / 64) * nblk;
    for (int it = gw; it < items; it += NGW) { const int kb = it / nblk, nb = it % nblk;
        transpose_item(src, N, 64 * kb, 32 * nb, dst, K, 32 * nb, 64 * kb, 32 * nb >= N, scr, lane); }
}
__device__ __forceinline__ void convert_weights(const Args& a, int layer, float* scr, int gw, int NGW, int lane) {
    unsigned char* W = a.ws + WS_W; const int j = layer >> 1;
    if ((layer & 1) == 0) {
        conv_plain(a.in[I_EWIN] + (size_t)j * D * EVEN_IN, D, EVEN_IN, EVEN_IN, (bf16_t*)(W + W_IN), scr, gw, NGW, lane);
        conv_plain(a.in[I_EWOUT] + (size_t)j * EVEN_MIX * D, EVEN_MIX, D, D, (bf16_t*)(W + W_OUT), scr, gw, NGW, lane);
        {
            const float* pw = a.in[I_POOLW] + (size_t)j * 4 * 128 * 128; bf16_t* dst = (bf16_t*)(W + W_POOL);
            for (int it = gw; it < 16 * 4; it += NGW) { const int nb = it >> 2, kb = it & 3, g = nb >> 2; const bool nz = (kb >> 1) == (g & 1);
                transpose_item(pw + (size_t)g * 128 * 128, 128, 64 * (kb & 1), 32 * (nb & 3), dst, 256, 32 * nb, 64 * kb, !nz, scr, lane); }
        }
        {
            const float* wa = a.in[I_WA] + (size_t)j * 8 * 128 * 128; const float* wx = a.in[I_WX] + (size_t)j * 8 * 128 * 128; bf16_t* dst = (bf16_t*)(W + W_GATE);
            for (int it = gw; it < 64 * 4; it += NGW) { const int nb = it >> 2, kb = it & 3, h = nb >> 3, half = (nb >> 2) & 1; const bool nz = (kb >> 1) == (h & 1);
                transpose_item((half ? wx : wa) + (size_t)h * 128 * 128, 128, 64 * (kb & 1), 32 * (nb & 3), dst, 256, 32 * nb, 64 * kb, !nz, scr, lane); }
        }
        {
            float* sp = (float*)(a.ws + WS_SP); const float* lam = a.in[I_LAM] + (size_t)j * LRUW;
            for (int i = gw * 64 + lane; i < LRUW; i += NGW * 64) { const float l = lam[i]; sp[i] = -8.0f * (l > 15.f ? expf(-l) : log1pf(expf(-l))); }
        }
    } else {
        conv_plain(a.in[I_WDOWN] + (size_t)j * D * ODD_IN, D, ODD_IN, ODD_IN_PAD, (bf16_t*)(W + W_DOWN), scr, gw, NGW, lane);
        conv_plain(a.in[I_WO] + (size_t)j * D * D, D, D, D, (bf16_t*)(W + W_O), scr, gw, NGW, lane);
        {
            const float* wq = a.in[I_WQB] + (size_t)j * QL * (NH * DQK); bf16_t* dst = (bf16_t*)(W + W_QB);
            for (int it = gw; it < 6 * 48; it += NGW) { const int kb = it / 48, nb = it % 48, n0 = 32 * nb; int sc;
                if (n0 < 1024) sc = (n0 >> 7) * DQK + (n0 & 127);
                else { const int m = n0 - 1024, p = m >> 8, half = (m >> 7) & 1, hl = (m >> 5) & 3; sc = (4 * p + hl) * DQK + 128 + half * 32; }
                transpose_item(wq, NH * DQK, 64 * kb, sc, dst, QL, n0, 64 * kb, false, scr, lane); }
        }
        {
            const float* wkv = a.in[I_WKVB] + (size_t)j * KVL * (NH * 256); bf16_t* dst = (bf16_t*)(W + W_KVB);
            for (int it = gw; it < 4 * 64; it += NGW) { const int kb = it / 64, nb = it % 64, n0 = 32 * nb; const int m = n0 & 1023;
                const int sc = (m >> 7) * 256 + (n0 >= 1024 ? 128 : 0) + (m & 127);
                transpose_item(wkv, NH * 256, 64 * kb, sc, dst, KVL, n0, 64 * kb, false, scr, lane); }
        }
    }
    conv_plain(a.in[I_W1] + (size_t)layer * D * FF, D, FF, FF, (bf16_t*)(W + W_1), scr, gw, NGW, lane);
    conv_plain(a.in[I_W2] + (size_t)layer * FF * D, FF, D, D, (bf16_t*)(W + W_2), scr, gw, NGW, lane);
}

__device__ __forceinline__ void ln_row(float* xrow, bf16_t* brow, const float* g, const float* b, int lane) {
    f32x4 v[4]; float s = 0.f;
#pragma unroll
    for (int j = 0; j < 4; ++j) { v[j] = *(const f32x4*)(xrow + 4 * lane + 256 * j); s += (v[j][0] + v[j][1]) + (v[j][2] + v[j][3]); }
    const float mean = wave_sum(s) * (1.f / D); float s2 = 0.f;
#pragma unroll
    for (int j = 0; j < 4; ++j) { v[j] = v[j] - mean; s2 += (v[j][0] * v[j][0] + v[j][1] * v[j][1]) + (v[j][2] * v[j][2] + v[j][3] * v[j][3]); }
    const float rstd = 1.0f / sqrtf(wave_sum(s2) * (1.f / D) + LN_EPS);
#pragma unroll
    for (int j = 0; j < 4; ++j) { const f32x4 gg = *(const f32x4*)(g + 4 * lane + 256 * j), bb = *(const f32x4*)(b + 4 * lane + 256 * j);
        const f32x4 o = v[j] * rstd * gg + bb; *(f32x4*)(xrow + 4 * lane + 256 * j) = o; *(u32x2*)(brow + 4 * lane + 256 * j) = pack4(o); }
}
__device__ __forceinline__ void ln_phase(const Args& a, const float* g, const float* b, int gw, int NGW, int lane) {
    bf16_t* XB = (bf16_t*)(a.ws + WS_XB);
    for (int m = gw; m < M; m += NGW) ln_row(a.out + (size_t)m * D, XB + (size_t)m * D, g, b, lane);
}
__device__ __forceinline__ void prologue_phase(const Args& a, int gw, int NGW, int lane) {
    bf16_t* XB = (bf16_t*)(a.ws + WS_XB); const float* x = a.in[I_X];
    for (int m = gw; m < M; m += NGW) {
#pragma unroll
        for (int j = 0; j < 4; ++j) { const f32x4 v = *(const f32x4*)(x + (size_t)m * D + 4 * lane + 256 * j); *(u32x2*)(XB + (size_t)m * D + 4 * lane + 256 * j) = pack4(v); }
    }
    float* COS = (float*)(a.ws + WS_COS); float* SIN = (float*)(a.ws + WS_SIN); const int* pos = (const int*)a.in[I_POS];
    for (int i = gw * 64 + lane; i < M * 32; i += NGW * 64) { const int m = i >> 5, f = i & 31;
        const float inv = powf(10000.0f, -(float)(2 * f) / 64.0f); const float ang = (float)pos[m] * inv;
        COS[i] = cosf(ang); SIN[i] = sinf(ang); }
}
__device__ __forceinline__ void convpool_phase(const Args& a, int layer) {
    const int j = layer >> 1;
    const bf16_t* P1 = (const bf16_t*)(a.ws + WS_BIG + B_P1); bf16_t* DU = (bf16_t*)(a.ws + WS_BIG + B_DU);
    const float* cw = a.in[I_CONVW] + (size_t)j * 4 * LRUW; const float* cb = a.in[I_CONVB] + (size_t)j * LRUW;
    const int nitems = M * 192;
    for (int it = blockIdx.x * 512 + threadIdx.x; it < nitems; it += gridDim.x * 512) {
        const int m = it / 192, c8 = it % 192, t = m & (SEQ - 1);
        float o[8];
        if (c8 < 64) {
            const int c = 8 * c8, w = 2 << (c8 >> 4), n = (t + 1 < w) ? (t + 1) : w;
            float s[8], cur[8];
#pragma unroll
            for (int e = 0; e < 8; ++e) s[e] = 0.f;
            for (int k = 0; k < n; ++k) { const u32x4 v = *(const u32x4*)(P1 + (size_t)(m - k) * EVEN_MIX + c);
                const float f[8] = {bflo(v.x), bfhi(v.x), bflo(v.y), bfhi(v.y), bflo(v.z), bfhi(v.z), bflo(v.w), bfhi(v.w)};
#pragma unroll
                for (int e = 0; e < 8; ++e) { s[e] += f[e]; if (k == 0) cur[e] = f[e]; } }
            const float inv = 1.0f / (float)n;
#pragma unroll
            for (int e = 0; e < 8; ++e) o[e] = s[e] * inv - cur[e];
            u32x4 w4; w4.x = cvt_pk_bf16(o[0], o[1]); w4.y = cvt_pk_bf16(o[2], o[3]); w4.z = cvt_pk_bf16(o[4], o[5]); w4.w = cvt_pk_bf16(o[6], o[7]);
            *(u32x4*)(DU + (size_t)m * EVEN_MIX + c) = w4;
        } else {
            const int ch = 8 * (c8 - 64);
#pragma unroll
            for (int e = 0; e < 8; ++e) o[e] = cb[ch + e];
#pragma unroll
            for (int k = 0; k < 4; ++k) { const int dt = 3 - k; if (t - dt >= 0) {
                const u32x4 v = *(const u32x4*)(P1 + (size_t)(m - dt) * EVEN_MIX + POOLW + ch);
                const float f[8] = {bflo(v.x), bfhi(v.x), bflo(v.y), bfhi(v.y), bflo(v.z), bfhi(v.z), bflo(v.w), bfhi(v.w)};
#pragma unroll
                for (int e = 0; e < 8; ++e) o[e] += cw[k * LRUW + ch + e] * f[e]; } }
            u32x4 w4; w4.x = cvt_pk_bf16(o[0], o[1]); w4.y = cvt_pk_bf16(o[2], o[3]); w4.z = cvt_pk_bf16(o[4], o[5]); w4.w = cvt_pk_bf16(o[6], o[7]);
            *(u32x4*)(DU + (size_t)m * EVEN_MIX + POOLW + ch) = w4;
        }
    }
}
constexpr int SC_NCH = 32, SC_LEN = 64;
__device__ __forceinline__ void scan_phase(const Args& a, int pass) {
    const bf16_t* LOGA = (const bf16_t*)(a.ws + WS_BIG + B_LOGA); bf16_t* XL = (bf16_t*)(a.ws + WS_BIG + B_XL); const bf16_t* G = (const bf16_t*)(a.ws + WS_BIG + B_G);
    float* CA = (float*)(a.ws + WS_CARRY); float* CH = (float*)(a.ws + WS_CARRY + 1 * MiB);
    const int nitems = NBATCH * SC_NCH * (LRUW / 2);
    for (int it = blockIdx.x * 512 + threadIdx.x; it < nitems; it += gridDim.x * 512) {
        const int c2 = it % (LRUW / 2), chunk = (it / (LRUW / 2)) % SC_NCH, b = it / ((LRUW / 2) * SC_NCH), ch = 2 * c2;
        const size_t m0 = (size_t)b * SEQ + (size_t)chunk * SC_LEN;
        float h0 = 0.f, h1 = 0.f;
        if (pass == 1) {
            float A0 = 1.f, A1 = 1.f;
#pragma unroll 8
            for (int t = 0; t < SC_LEN; ++t) { const unsigned la = *(const unsigned*)(LOGA + (m0 + t) * LRUW + ch), xi = *(const unsigned*)(XL + (m0 + t) * EVEN_MIX + POOLW + ch);
                const float a0 = __builtin_amdgcn_exp2f(bflo(la)), a1 = __builtin_amdgcn_exp2f(bfhi(la));
                h0 = a0 * h0 + bflo(xi); h1 = a1 * h1 + bfhi(xi); A0 *= a0; A1 *= a1; }
            const size_t ci = ((size_t)b * SC_NCH + chunk) * LRUW + ch;
            *(f32x2*)(CA + ci) = (f32x2){A0, A1}; *(f32x2*)(CH + ci) = (f32x2){h0, h1};
        } else {
            for (int c = 0; c < chunk; ++c) { const size_t ci = ((size_t)b * SC_NCH + c) * LRUW + ch; const f32x2 A = *(const f32x2*)(CA + ci), H = *(const f32x2*)(CH + ci);
                h0 = A[0] * h0 + H[0]; h1 = A[1] * h1 + H[1]; }
#pragma unroll 8
            for (int t = 0; t < SC_LEN; ++t) { const unsigned la = *(const unsigned*)(LOGA + (m0 + t) * LRUW + ch), xi = *(const unsigned*)(XL + (m0 + t) * EVEN_MIX + POOLW + ch), gg = *(const unsigned*)(G + (m0 + t) * LRUW + ch);
                const float a0 = __builtin_amdgcn_exp2f(bflo(la)), a1 = __builtin_amdgcn_exp2f(bfhi(la));
                h0 = a0 * h0 + bflo(xi); h1 = a1 * h1 + bfhi(xi);
                *(unsigned*)(XL + (m0 + t) * EVEN_MIX + POOLW + ch) = cvt_pk_bf16(h0 * bflo(gg), h1 * bfhi(gg)); }
        }
    }
}
__device__ __forceinline__ void rmsrope_phase(const Args& a, int layer, int gw, int NGW, int lane) {
    const int j = layer >> 1;
    const float* DOWN = (const float*)(a.ws + WS_BIG + B_DOWN); bf16_t* CQ = (bf16_t*)(a.ws + WS_BIG + B_CQ); bf16_t* CKV = (bf16_t*)(a.ws + WS_BIG + B_CKV); bf16_t* KPE = (bf16_t*)(a.ws + WS_BIG + B_KPE);
    const float* qg = a.in[I_QNG] + (size_t)j * QL; const float* kg = a.in[I_KVNG] + (size_t)j * KVL;
    const float* COS = (const float*)(a.ws + WS_COS); const float* SIN = (const float*)(a.ws + WS_SIN);
    for (int m = gw; m < M; m += NGW) {
        const float* dr = DOWN + (size_t)m * ODD_IN_PAD;
        f32x2 q[3]; float ss = 0.f;
#pragma unroll
        for (int i = 0; i < 3; ++i) { q[i] = *(const f32x2*)(dr + 128 * i + 2 * lane); ss += q[i][0] * q[i][0] + q[i][1] * q[i][1]; }
        const float rq = 1.0f / sqrtf(wave_sum(ss) * (1.f / QL) + RMS_EPS);
#pragma unroll
        for (int i = 0; i < 3; ++i) { const f32x2 gg = *(const f32x2*)(qg + 128 * i + 2 * lane); *(unsigned*)(CQ + (size_t)m * QL + 128 * i + 2 * lane) = cvt_pk_bf16(q[i][0] * rq * gg[0], q[i][1] * rq * gg[1]); }
        const f32x4 kv = *(const f32x4*)(dr + QL + 4 * lane);
        const float rk = 1.0f / sqrtf(wave_sum((kv[0] * kv[0] + kv[1] * kv[1]) + (kv[2] * kv[2] + kv[3] * kv[3])) * (1.f / KVL) + RMS_EPS);
        const f32x4 gk = *(const f32x4*)(kg + 4 * lane);
        *(u32x2*)(CKV + (size_t)m * KVL + 4 * lane) = pack4(kv * rk * gk);
        const int i = lane & 31; const float x1 = dr[QL + KVL + i], x2 = dr[QL + KVL + 32 + i], c = COS[(size_t)m * 32 + i], s = SIN[(size_t)m * 32 + i];
        const float o = (lane < 32) ? (x1 * c - x2 * s) : (x1 * s + x2 * c);
        const float o_nb = __shfl_xor(o, 1);
        if ((lane & 1) == 0) *(unsigned*)(KPE + (size_t)m * ROPE + lane) = cvt_pk_bf16(o, o_nb);
    }
}
__device__ __forceinline__ void attn_naive_phase(const Args& a, float* lds_f, int gw, int NGW, int lane, int wave) {
    const bf16_t* Q = (const bf16_t*)(a.ws + WS_BIG + B_Q); const bf16_t* KN = (const bf16_t*)(a.ws + WS_BIG + B_KN); const bf16_t* KPE = (const bf16_t*)(a.ws + WS_BIG + B_KPE);
    const bf16_t* V = (const bf16_t*)(a.ws + WS_BIG + B_V); bf16_t* O = (bf16_t*)(a.ws + WS_BIG + B_O);
    float* qs = lds_f + wave * (192 + 2048); float* ps = qs + 192;
    for (int it = gw; it < M * NH; it += NGW) {
        const int h = it & 7, m = it >> 3, b = m / SEQ, t = m % SEQ, nk = 64 * (t / 64 + 1);
        for (int i = lane; i < DQK; i += 64) qs[i] = bf2f(Q[(size_t)m * (NH * DQK) + h * DQK + i]);
        asm volatile("s_waitcnt lgkmcnt(0)" ::: "memory");
        float mx = -3.0e38f;
        for (int kk = lane; kk < nk; kk += 64) { const size_t kr = (size_t)b * SEQ + kk; float s = 0.f;
            for (int d = 0; d < 128; d += 8) { const u32x4 v = *(const u32x4*)(KN + kr * D + h * 128 + d);
                s += qs[d] * bflo(v.x) + qs[d + 1] * bfhi(v.x) + qs[d + 2] * bflo(v.y) + qs[d + 3] * bfhi(v.y) + qs[d + 4] * bflo(v.z) + qs[d + 5] * bfhi(v.z) + qs[d + 6] * bflo(v.w) + qs[d + 7] * bfhi(v.w); }
            for (int d = 0; d < 64; d += 8) { const u32x4 v = *(const u32x4*)(KPE + kr * ROPE + d); const float* qq = qs + 128 + d;
                s += qq[0] * bflo(v.x) + qq[1] * bfhi(v.x) + qq[2] * bflo(v.y) + qq[3] * bfhi(v.y) + qq[4] * bflo(v.z) + qq[5] * bfhi(v.z) + qq[6] * bflo(v.w) + qq[7] * bfhi(v.w); }
            ps[kk] = s; mx = fmaxf(mx, s); }
        mx = wave_max(mx);
        float l = 0.f;
        for (int kk = lane; kk < nk; kk += 64) { const float e = __builtin_amdgcn_exp2f(ps[kk] - mx); ps[kk] = e; l += e; }
        l = wave_sum(l);
        asm volatile("s_waitcnt lgkmcnt(0)" ::: "memory");
        float o0 = 0.f, o1 = 0.f;
        for (int kk = 0; kk < nk; ++kk) { const unsigned v = *(const unsigned*)(V + ((size_t)b * SEQ + kk) * D + h * 128 + 2 * lane); const float p = ps[kk]; o0 += p * bflo(v); o1 += p * bfhi(v); }
        const float il = 1.0f / l;
        *(unsigned*)(O + (size_t)m * D + h * 128 + 2 * lane) = cvt_pk_bf16(o0 * il, o1 * il);
        asm volatile("s_waitcnt lgkmcnt(0)" ::: "memory");
    }
}

constexpr int AT_KPITCH = 400, AT_VPITCH = 144, AT_KBYTES = 64 * AT_KPITCH, AT_BUF = AT_KBYTES + 128 * AT_VPITCH;
static_assert(2 * AT_BUF <= RING_BYTES, "attention LDS");
__device__ __forceinline__ void attn_unit(const bf16_t* Q, const bf16_t* KN, const bf16_t* KPE, const bf16_t* V, bf16_t* O, LAS unsigned char* lds, int b, int h, int qb, int tid, int lane, int wave) {
    const int r = lane & 31, hi = lane >> 5;
    const size_t row0 = (size_t)b * SEQ;
    const int q0 = qb * 256 + wave * 32;
    bf16x8 qf[12];
    { const bf16_t* qp = Q + (row0 + q0 + r) * (size_t)(NH * DQK) + h * DQK + 8 * hi;
#pragma unroll
      for (int ks = 0; ks < 12; ++ks) qf[ks] = *(const bf16x8*)(qp + 16 * ks); }
    const int NT = 4 * (qb + 1), cw = 4 * qb + (wave >> 1);
    const int kr0 = tid >> 4, kc = tid & 15, pr = tid >> 3, pc = tid & 7;
    const bf16_t* kn_src = KN + (row0 + kr0) * (size_t)D + h * 128 + kc * 8;
    const bf16_t* v_src = V + (row0 + kr0) * (size_t)D + h * 128 + kc * 8;
    const bf16_t* pe_src = KPE + (row0 + pr) * (size_t)ROPE + pc * 8;
    const int k_dst = kr0 * AT_KPITCH + kc * 16, pe_dst = pr * AT_KPITCH + 256 + pc * 16;
    const int pos0 = (kr0 & ~12) | ((kr0 & 4) << 1) | ((kr0 & 8) >> 1);
    const int v_dst = AT_KBYTES + (kc * 8) * AT_VPITCH + pos0 * 2;
    u32x4 sk0, sk1, sv0, sv1, spe;
#define AT_LOAD(t) do { const size_t o_ = (size_t)(t) * 64 * D; sk0 = *(const u32x4*)(kn_src + o_); sk1 = *(const u32x4*)(kn_src + o_ + 32 * D); sv0 = *(const u32x4*)(v_src + o_); sv1 = *(const u32x4*)(v_src + o_ + 32 * D); \
        spe = *(const u32x4*)(pe_src + (size_t)(t) * 64 * ROPE); } while (0)
#define AT_VT(base, v) do { LAS unsigned short* p_ = (LAS unsigned short*)(base); \
        p_[0 * (AT_VPITCH / 2)] = (unsigned short)((v).x); p_[1 * (AT_VPITCH / 2)] = (unsigned short)((v).x >> 16); p_[2 * (AT_VPITCH / 2)] = (unsigned short)((v).y); p_[3 * (AT_VPITCH / 2)] = (unsigned short)((v).y >> 16); \
        p_[4 * (AT_VPITCH / 2)] = (unsigned short)((v).z); p_[5 * (AT_VPITCH / 2)] = (unsigned short)((v).z >> 16); p_[6 * (AT_VPITCH / 2)] = (unsigned short)((v).w); p_[7 * (AT_VPITCH / 2)] = (unsigned short)((v).w >> 16); } while (0)
#define AT_WRITE(buf) do { LAS unsigned char* B_ = lds + (buf) * AT_BUF; *(LAS u32x4*)(B_ + k_dst) = sk0; *(LAS u32x4*)(B_ + k_dst + 32 * AT_KPITCH) = sk1; *(LAS u32x4*)(B_ + pe_dst) = spe; \
        AT_VT(B_ + v_dst, sv0); AT_VT(B_ + v_dst + 64, sv1); } while (0)
    f32x16 o[4];
#pragma unroll
    for (int i = 0; i < 4; ++i) o[i] = (f32x16){};
    float mrun = -1.0e30f, l = 0.f;
    AT_LOAD(0); AT_WRITE(0);
    __syncthreads();
    for (int t = 0; t < NT; ++t) {
        const int buf = t & 1;
        if (t + 1 < NT) AT_LOAD(t + 1);
        if (t <= cw) {
            const LAS unsigned char* Kb = lds + buf * AT_BUF + r * AT_KPITCH + hi * 16;
            f32x16 p0 = (f32x16){}, p1 = (f32x16){};
#pragma unroll
            for (int ks = 0; ks < 12; ++ks) {
                const bf16x8 a0 = *(const LAS bf16x8*)(Kb + ks * 32), a1 = *(const LAS bf16x8*)(Kb + 32 * AT_KPITCH + ks * 32);
                p0 = __builtin_amdgcn_mfma_f32_32x32x16_bf16(a0, qf[ks], p0, 0, 0, 0);
                p1 = __builtin_amdgcn_mfma_f32_32x32x16_bf16(a1, qf[ks], p1, 0, 0, 0);
            }
            float mloc = fmaxf(p0[0], p1[0]);
#pragma unroll
            for (int i = 1; i < 16; ++i) mloc = fmaxf(mloc, fmaxf(p0[i], p1[i]));
            const float mt = fmaxf(mloc, __shfl_xor(mloc, 32));
            const float mnew = fmaxf(mrun, mt);
            const float alpha = __builtin_amdgcn_exp2f(mrun - mnew);
            if (__any(mnew > mrun)) {
#pragma unroll
                for (int d = 0; d < 4; ++d)
#pragma unroll
                    for (int i = 0; i < 16; ++i) o[d][i] *= alpha;
            }
            l *= alpha; mrun = mnew;
            float ls = 0.f;
#pragma unroll
            for (int i = 0; i < 16; ++i) { p0[i] = __builtin_amdgcn_exp2f(p0[i] - mnew); p1[i] = __builtin_amdgcn_exp2f(p1[i] - mnew); ls += p0[i] + p1[i]; }
            l += ls;
            bf16x8 pf[4];
#pragma unroll
            for (int s2 = 0; s2 < 2; ++s2) {
                u32x4 w0, w1;
                w0.x = cvt_pk_bf16(p0[8 * s2 + 0], p0[8 * s2 + 1]); w0.y = cvt_pk_bf16(p0[8 * s2 + 2], p0[8 * s2 + 3]); w0.z = cvt_pk_bf16(p0[8 * s2 + 4], p0[8 * s2 + 5]); w0.w = cvt_pk_bf16(p0[8 * s2 + 6], p0[8 * s2 + 7]);
                w1.x = cvt_pk_bf16(p1[8 * s2 + 0], p1[8 * s2 + 1]); w1.y = cvt_pk_bf16(p1[8 * s2 + 2], p1[8 * s2 + 3]); w1.z = cvt_pk_bf16(p1[8 * s2 + 4], p1[8 * s2 + 5]); w1.w = cvt_pk_bf16(p1[8 * s2 + 6], p1[8 * s2 + 7]);
                pf[s2] = __builtin_bit_cast(bf16x8, w0); pf[2 + s2] = __builtin_bit_cast(bf16x8, w1);
            }
            const LAS unsigned char* Vb = lds + buf * AT_BUF + AT_KBYTES + r * AT_VPITCH + hi * 16;
#pragma unroll
            for (int d = 0; d < 4; ++d)
#pragma unroll
                for (int ks = 0; ks < 4; ++ks) {
                    const bf16x8 a = *(const LAS bf16x8*)(Vb + d * 32 * AT_VPITCH + ks * 32);
                    o[d] = __builtin_amdgcn_mfma_f32_32x32x16_bf16(a, pf[ks], o[d], 0, 0, 0);
                }
        }
        if (t + 1 < NT) AT_WRITE(buf ^ 1);
        __syncthreads();
    }
    const float ltot = l + __shfl_xor(l, 32);
    const float inv = 1.0f / ltot;
    bf16_t* op = O + (row0 + q0 + r) * (size_t)D + h * 128 + 4 * hi;
#pragma unroll
    for (int d = 0; d < 4; ++d)
#pragma unroll
        for (int g4 = 0; g4 < 4; ++g4) {
            const f32x4 v = {o[d][4 * g4] * inv, o[d][4 * g4 + 1] * inv, o[d][4 * g4 + 2] * inv, o[d][4 * g4 + 3] * inv};
            *(u32x2*)(op + 32 * d + 8 * g4) = pack4(v);
        }
#undef AT_LOAD
#undef AT_VT
#undef AT_WRITE
}
__device__ __forceinline__ void attn_phase(const Args& a, LAS unsigned char* lds) {
    int tid_ = threadIdx.x; asm volatile("" : "+v"(tid_));
    const int tid = tid_, lane = tid & 63, wave = __builtin_amdgcn_readfirstlane(tid >> 6);
    const bf16_t* Q = (const bf16_t*)(a.ws + WS_BIG + B_Q); const bf16_t* KN = (const bf16_t*)(a.ws + WS_BIG + B_KN); const bf16_t* KPE = (const bf16_t*)(a.ws + WS_BIG + B_KPE);
    const bf16_t* V = (const bf16_t*)(a.ws + WS_BIG + B_V); bf16_t* O = (bf16_t*)(a.ws + WS_BIG + B_O);
    const int G = gridDim.x, bx = blockIdx.x;
    for (int c = bx; c < 256; c += G) {
        const int vc = (c & 7) * 32 + (c >> 3);
        const int bh = vc >> 2, s = vc & 3;
        attn_unit(Q, KN, KPE, V, O, lds, bh >> 3, bh & 7, 7 - s, tid, lane, wave);
        attn_unit(Q, KN, KPE, V, O, lds, bh >> 3, bh & 7, s, tid, lane, wave);
    }
}

#ifndef GEMM_MASK
#define GEMM_MASK (USE_FAST_GEMM ? 0x3ff : 0)
#endif
template <int ID, class Epi>
__device__ __forceinline__ void run_gemm(LAS unsigned char* lds, const Gemm g, const Epi& E) {
    if constexpr ((GEMM_MASK >> ID) & 1) {
        pg8::StaticOrder S; S.init(g.M, g.N, (int)gridDim.x, (int)blockIdx.x);
        pg8::gemm_phase<Epi>(lds, g, S, E);
    } else {
        sgemm_phase<Epi>(g, E);
    }
}
constexpr int N_PHASES = 39;
__host__ __device__ constexpr int phase_base(int layer) { return layer == 0 ? 1 : layer == 1 ? 11 : layer == 2 ? 20 : 30; }
#if MK_ONE_LAUNCH
#define SEAM(k) do { if (lo <= (k) && (k) + 1 < hi) xcd_barrier(bar); } while (0)
#else
#define SEAM(k) do { } while (0)
#endif
#define IN(k) (lo <= (k) && (k) < hi)
template <int LAYER>
__device__ __forceinline__ void run_layer(const Args& args, LAS unsigned char* ldsl, unsigned char* lds, const XcdBarrier& bar, int lo, int hi, int gw, int NGW, int lane, int wave) {
    constexpr int base = phase_base(LAYER); constexpr bool even = (LAYER & 1) == 0; constexpr int j = LAYER >> 1;
    unsigned char* ws = args.ws; unsigned char* W = ws + WS_W; unsigned char* BIG = ws + WS_BIG; bf16_t* XB = (bf16_t*)(ws + WS_XB);
    const float* xres = (LAYER == 0) ? args.in[I_X] : (const float*)args.out;
    constexpr int nmix = even ? 6 : 5;
    if constexpr (even) {
        if (IN(base + 0)) { Gemm g{XB, (const bf16_t*)(W + W_IN), M, EVEN_IN, D, D, D, 0, 0}; EpiIn E{(bf16_t*)(BIG + B_P1), (bf16_t*)(BIG + B_G)}; run_gemm<0>(ldsl, g, E); }
        SEAM(base + 0);
        if (IN(base + 1)) convpool_phase(args, LAYER);
        SEAM(base + 1);
        if (IN(base + 2)) {
            { Gemm g{(const bf16_t*)(BIG + B_DU), (const bf16_t*)(W + W_POOL), M, POOLW, 256, EVEN_MIX, 256, 0, 256}; EpiPool E{(bf16_t*)(BIG + B_XL), args.in[I_POOLS] + (size_t)j * POOLW}; run_gemm<1>(ldsl, g, E); }
            { Gemm g{(const bf16_t*)(BIG + B_DU) + POOLW, (const bf16_t*)(W + W_GATE), M, 2048, 256, EVEN_MIX, 256, 1, 256};
              EpiGate E{(const bf16_t*)(BIG + B_DU), (bf16_t*)(BIG + B_LOGA), (bf16_t*)(BIG + B_XL), args.in[I_BA] + (size_t)j * LRUW, args.in[I_BX] + (size_t)j * LRUW, (const float*)(ws + WS_SP)}; run_gemm<2>(ldsl, g, E); }
        }
        SEAM(base + 2);
        if (IN(base + 3)) scan_phase(args, 1);
        SEAM(base + 3);
        if (IN(base + 4)) scan_phase(args, 2);
        SEAM(base + 4);
        if (IN(base + 5)) { Gemm g{(const bf16_t*)(BIG + B_XL), (const bf16_t*)(W + W_OUT), M, D, EVEN_MIX, EVEN_MIX, EVEN_MIX, 0, 0}; EpiRes E{xres, args.out}; run_gemm<3>(ldsl, g, E); }
        SEAM(base + 5);
    } else {
        if (IN(base + 0)) { Gemm g{XB, (const bf16_t*)(W + W_DOWN), M, ODD_IN_PAD, D, D, D, 0, 0}; EpiDown E{(float*)(BIG + B_DOWN)}; run_gemm<4>(ldsl, g, E); }
        SEAM(base + 0);
        if (IN(base + 1)) rmsrope_phase(args, LAYER, gw, NGW, lane);
        SEAM(base + 1);
        if (IN(base + 2)) {
            { Gemm g{(const bf16_t*)(BIG + B_CQ), (const bf16_t*)(W + W_QB), M, NH * DQK, QL, QL, QL, 0, 0}; EpiQ E{(bf16_t*)(BIG + B_Q), (const float*)(ws + WS_COS), (const float*)(ws + WS_SIN)}; run_gemm<5>(ldsl, g, E); }
            { Gemm g{(const bf16_t*)(BIG + B_CKV), (const bf16_t*)(W + W_KVB), M, 2048, KVL, KVL, KVL, 0, 0}; EpiKV E{(bf16_t*)(BIG + B_KN), (bf16_t*)(BIG + B_V)}; run_gemm<6>(ldsl, g, E); }
        }
        SEAM(base + 2);
#if USE_NAIVE_ATTN
        if (IN(base + 3)) attn_naive_phase(args, (float*)lds, gw, NGW, lane, wave);
#else
        if (IN(base + 3)) attn_phase(args, ldsl);
#endif
        SEAM(base + 3);
        if (IN(base + 4)) { Gemm g{(const bf16_t*)(BIG + B_O), (const bf16_t*)(W + W_O), M, D, D, D, D, 0, 0}; EpiRes E{xres, args.out}; run_gemm<7>(ldsl, g, E); }
        SEAM(base + 4);
    }
    if (IN(base + nmix)) ln_phase(args, args.in[I_LNMG] + (size_t)LAYER * D, args.in[I_LNMB] + (size_t)LAYER * D, gw, NGW, lane);
    SEAM(base + nmix);
    if (IN(base + nmix + 1)) { Gemm g{XB, (const bf16_t*)(W + W_1), M, FF, D, D, D, 0, 0}; EpiRelu2 E{(bf16_t*)(BIG + B_H)}; run_gemm<8>(ldsl, g, E); }
    SEAM(base + nmix + 1);
    if (IN(base + nmix + 2)) { Gemm g{(const bf16_t*)(BIG + B_H), (const bf16_t*)(W + W_2), M, D, FF, FF, FF, 0, 0}; EpiRes E{(const float*)args.out, args.out}; run_gemm<9>(ldsl, g, E); }
    SEAM(base + nmix + 2);
    if (IN(base + nmix + 3)) { ln_phase(args, args.in[I_LNFG] + (size_t)LAYER * D, args.in[I_LNFB] + (size_t)LAYER * D, gw, NGW, lane);
        if constexpr (LAYER < 3) convert_weights(args, LAYER + 1, (float*)lds + wave * 4096, gw, NGW, lane); }
    if constexpr (LAYER < 3) SEAM(base + nmix + 3);
}
__global__ void __launch_bounds__(NWAVES * 64, 2) mega_fwd(Args args) {
    extern __shared__ __attribute__((aligned(16))) unsigned char lds[];
    LAS unsigned char* ldsl = (LAS unsigned char*)lds;
    const int tid = threadIdx.x, lane = tid & 63, wave = __builtin_amdgcn_readfirstlane(tid >> 6);
    const int gw = blockIdx.x * NWAVES + wave, NGW = gridDim.x * NWAVES;
    unsigned char* ws = args.ws;
    volatile LAS unsigned* MISC = (volatile LAS unsigned*)(ldsl + MISC_OFF);
    for (int u = tid; u < (LDS_BYTES - LDSCTL_OFF) / 4; u += NWAVES * 64) ((LAS unsigned*)(ldsl + LDSCTL_OFF))[u] = 0u;
    __syncthreads();
    XcdBarrier bar; bar.bar = (unsigned*)(ws + WS_CTL) + CW_BAR; bar.x = 0; bar.st = nullptr;
#if MK_ONE_LAUNCH
    bar = xcd_barrier_post((unsigned*)(ws + WS_CTL) + CW_BAR, MISC + 8);
#else
    (void)MISC;
#endif
    const int lo = args.ph_lo, hi = args.ph_hi;
    if (IN(0)) { convert_weights(args, 0, (float*)lds + wave * 4096, gw, NGW, lane); prologue_phase(args, gw, NGW, lane); }
    SEAM(0);
    run_layer<0>(args, ldsl, lds, bar, lo, hi, gw, NGW, lane, wave);
    run_layer<1>(args, ldsl, lds, bar, lo, hi, gw, NGW, lane, wave);
    run_layer<2>(args, ldsl, lds, bar, lo, hi, gw, NGW, lane, wave);
    run_layer<3>(args, ldsl, lds, bar, lo, hi, gw, NGW, lane, wave);
}
#undef IN
#undef SEAM

extern "C" void kernel_launch(void* const* d_in, const int* in_sizes, int n_in, void* d_out, int out_size, void* d_ws, size_t ws_size, hipStream_t stream) {
    static int grid = 0;
    if (grid == 0) {
        if (n_in != 25 || in_sizes[0] != M * D || out_size != M * D || ws_size < WS_END) { fprintf(stderr, "kernel_launch: unexpected shapes: n_in %d in0 %d out %d ws %zu\n", n_in, n_in > 0 ? in_sizes[0] : -1, out_size, ws_size); grid = -1; return; }
        int dev = 0, cus = 0, per_cu = 0;
        if (hipGetDevice(&dev) != hipSuccess || hipDeviceGetAttribute(&cus, hipDeviceAttributeMultiprocessorCount, dev) != hipSuccess) { grid = -1; return; }
        if (hipFuncSetAttribute((const void*)mega_fwd, hipFuncAttributeMaxDynamicSharedMemorySize, LDS_BYTES) != hipSuccess) { fprintf(stderr, "kernel_launch: hipFuncSetAttribute failed\n"); grid = -1; return; }
        if (hipOccupancyMaxActiveBlocksPerMultiprocessor(&per_cu, (const void*)mega_fwd, NWAVES * 64, LDS_BYTES) != hipSuccess || per_cu < 1) { fprintf(stderr, "kernel_launch: occupancy query says %d blocks per CU\n", per_cu); per_cu = 1; }
        (void)hipGetLastError();
        grid = cus;
    }
    if (grid < 0) return;
    (void)hipMemsetAsync((char*)d_ws + WS_CTL, 0, CTL_ZERO_BYTES, stream);
    Args a{};
    for (int i = 0; i < 25; ++i) a.in[i] = (const float*)d_in[i];
    a.out = (float*)d_out; a.ws = (unsigned char*)d_ws;
#if MK_ONE_LAUNCH
    a.ph_lo = 0; a.ph_hi = N_PHASES;
    void* kargs[] = {&a};
    hipError_t e = hipLaunchCooperativeKernel((const void*)mega_fwd, dim3(grid), dim3(NWAVES * 64), kargs, LDS_BYTES, stream);
    if (e != hipSuccess) fprintf(stderr, "kernel_launch: cooperative launch failed: %s (grid %d)\n", hipGetErrorString(e), grid);
#else
    for (int ph = 0; ph < N_PHASES; ++ph) { a.ph_lo = ph; a.ph_hi = ph + 1; hipLaunchKernelGGL(mega_fwd, dim3(grid), dim3(NWAVES * 64), LDS_BYTES, stream, a); }
#endif
}
```
